# Optimizing an MI355X kernel written in HIP

```python
import jax, jax.numpy as jnp
from jax import lax
import numpy as np

D_MODEL = 2048
BATCH = 2
SEQ = 16384
DEPTH = 2

N_MIXERS = 2
CHUNK = 128
EPS = 1e-6
ROPE_BASE = 10000.0
RET_HEADS = 8
RET_QK_DIM = D_MODEL
RET_V_DIM = 2 * D_MODEL
RET_QK_HEAD = RET_QK_DIM // RET_HEADS
RET_V_HEAD = RET_V_DIM // RET_HEADS
RET_IN_DIM = 2 * RET_QK_DIM + 2 * RET_V_DIM
ML_INNER = 2 * D_MODEL
ML_HEADS = 4
ML_HEAD = ML_INNER // ML_HEADS
QKV_BLOCK = 4
N_QKV_BLOCKS = ML_INNER // QKV_BLOCK
CONV_WIDTH = 4
D_FF = -(-8 * D_MODEL // (3 * 256)) * 256
N_RET_LAYERS = (DEPTH + 1) // 2
N_ML_LAYERS = DEPTH // 2

kernel_name = 'retention_mlstm_interleaved_trunk'


def rms_norm(x, g):
    xf = x.astype(jnp.float32)
    y = xf * lax.rsqrt(jnp.mean(xf * xf, axis=-1, keepdims=True) + EPS)
    return (y * g.astype(jnp.float32)).astype(x.dtype)


def head_layer_norm(h, g):
    mu = jnp.mean(h, axis=-1, keepdims=True)
    var = jnp.mean(jnp.square(h - mu), axis=-1, keepdims=True)
    y = (h - mu) * lax.rsqrt(var + EPS)
    return y.reshape(h.shape[0], h.shape[1], -1) * g.astype(jnp.float32)


def to_chunks(t):
    b, s, h, d = t.shape
    return t.reshape(b, s // CHUNK, CHUNK, h, d).transpose(1, 0, 3, 2, 4)


def from_chunks(t):
    n, b, h, l, d = t.shape
    return t.transpose(1, 0, 3, 2, 4).reshape(b, n * l, h, d)


def rotary(t, cos, sin):
    half = t.shape[-1] // 2
    t1, t2 = t[..., :half], t[..., half:]
    return jnp.concatenate([t1 * cos - t2 * sin, t1 * sin + t2 * cos], axis=-1)


def retention_mixer(u, positions, w_in, gn_g, w_out):
    b, s, _ = u.shape
    f32 = jnp.float32
    q, k, v, g = jnp.split(u @ w_in, [RET_QK_DIM, 2 * RET_QK_DIM, 2 * RET_QK_DIM + RET_V_DIM], axis=-1)
    q = q.astype(f32).reshape(b, s, RET_HEADS, RET_QK_HEAD)
    k = k.astype(f32).reshape(b, s, RET_HEADS, RET_QK_HEAD)
    v = v.astype(f32).reshape(b, s, RET_HEADS, RET_V_HEAD)
    inv_freq = ROPE_BASE ** (-jnp.arange(RET_QK_HEAD // 2, dtype=f32) * (2.0 / RET_QK_HEAD))
    ang = positions.astype(f32)[..., None] * inv_freq
    cos = jnp.cos(ang)[:, :, None, :]
    sin = jnp.sin(ang)[:, :, None, :]
    q = rotary(q, cos, sin)
    k = rotary(k, cos, sin) * (RET_QK_HEAD ** -0.5)
    log_gamma = jnp.log(1.0 - 2.0 ** (-5.0 - jnp.arange(RET_HEADS, dtype=f32)))
    idx = jnp.arange(CHUNK, dtype=f32)
    rel = idx[:, None] - idx[None, :]
    d_intra = jnp.where(rel[None] >= 0, jnp.exp(jnp.maximum(rel, 0.0)[None] * log_gamma[:, None, None]), 0.0)
    xi = jnp.exp((idx + 1.0)[None] * log_gamma[:, None])
    zeta = jnp.exp((CHUNK - 1.0 - idx)[None] * log_gamma[:, None])
    chunk_decay = jnp.exp(CHUNK * log_gamma)

    def step(state, inp):
        qc, kc, vc = inp
        scores = jnp.einsum('bhid,bhjd->bhij', qc, kc) * d_intra
        out = (jnp.einsum('bhij,bhje->bhie', scores, vc)
               + jnp.einsum('bhid,bhde->bhie', qc * xi[None, :, :, None], state))
        state = (chunk_decay[None, :, None, None] * state
                 + jnp.einsum('bhjd,bhje->bhde', kc * zeta[None, :, :, None], vc))
        return state, out

    state0 = jnp.zeros((b, RET_HEADS, RET_QK_HEAD, RET_V_HEAD), f32)
    _, o = lax.scan(step, state0, (to_chunks(q), to_chunks(k), to_chunks(v)))
    y = head_layer_norm(from_chunks(o), gn_g)
    y = jax.nn.silu(g.astype(f32)) * y
    return y.astype(u.dtype) @ w_out


def mlstm_mixer(u, w_in, conv_w, conv_b, w_q, w_k, w_v, w_gate, b_gate, gn_g, skip, w_out):
    b, s, _ = u.shape
    f32 = jnp.float32
    xm, z = jnp.split(u @ w_in, 2, axis=-1)
    xp = jnp.pad(xm, ((0, 0), (CONV_WIDTH - 1, 0), (0, 0)))
    conv = conv_b + sum(xp[:, j:j + s, :] * conv_w[j] for j in range(CONV_WIDTH))
    xc = jax.nn.silu(conv)

    def block_diag(t, w):
        tb = t.reshape(b, s, N_QKV_BLOCKS, QKV_BLOCK)
        return jnp.einsum('bsni,noi->bsno', tb, w).reshape(b, s, ML_INNER)

    q = block_diag(xc, w_q)
    k = block_diag(xc, w_k)
    v = block_diag(xm, w_v)
    gates = (q @ w_gate[:ML_INNER] + k @ w_gate[ML_INNER:2 * ML_INNER]
             + v @ w_gate[2 * ML_INNER:] + b_gate).astype(f32)
    ig = gates[..., :ML_HEADS]
    log_f = jax.nn.log_sigmoid(gates[..., ML_HEADS:])

    def gate_chunks(t):
        return t.reshape(b, s // CHUNK, CHUNK, ML_HEADS).transpose(1, 0, 3, 2)

    ig_c = gate_chunks(ig)
    cum_f = jnp.cumsum(gate_chunks(log_f), axis=-1)
    qh = q.astype(f32).reshape(b, s, ML_HEADS, ML_HEAD)
    kh = k.astype(f32).reshape(b, s, ML_HEADS, ML_HEAD) * (ML_HEAD ** -0.5)
    vh = v.astype(f32).reshape(b, s, ML_HEADS, ML_HEAD)
    causal = jnp.tril(jnp.ones((CHUNK, CHUNK), dtype=bool))

    def step(carry, inp):
        c_mat, n_vec, m = carry
        qc, kc, vc, igc, bc = inp
        log_d = jnp.where(causal, bc[..., :, None] - bc[..., None, :] + igc[..., None, :], -jnp.inf)
        m_inter = bc + m[..., None]
        m_t = jnp.maximum(jnp.max(log_d, axis=-1), m_inter)
        scores = jnp.einsum('bhtd,bhsd->bhts', qc, kc) * jnp.exp(log_d - m_t[..., None])
        inter = jnp.exp(m_inter - m_t)
        num = (jnp.einsum('bhts,bhse->bhte', scores, vc)
               + inter[..., None] * jnp.einsum('bhtd,bhde->bhte', qc, c_mat))
        den = jnp.sum(scores, axis=-1) + inter * jnp.einsum('bhtd,bhd->bht', qc, n_vec)
        h = num / jnp.maximum(jnp.abs(den), jnp.exp(-m_t))[..., None]
        b_last = bc[..., -1]
        log_w = b_last[..., None] - bc + igc
        m_new = jnp.maximum(b_last + m, jnp.max(log_w, axis=-1))
        wts = jnp.exp(log_w - m_new[..., None])
        decay = jnp.exp(b_last + m - m_new)
        kw = kc * wts[..., None]
        c_mat = decay[..., None, None] * c_mat + jnp.einsum('bhsd,bhse->bhde', kw, vc)
        n_vec = decay[..., None] * n_vec + jnp.sum(kw, axis=-2)
        return (c_mat, n_vec, m_new), h

    carry0 = (jnp.zeros((b, ML_HEADS, ML_HEAD, ML_HEAD), f32),
              jnp.zeros((b, ML_HEADS, ML_HEAD), f32),
              jnp.zeros((b, ML_HEADS), f32))
    _, hc = lax.scan(step, carry0, (to_chunks(qh), to_chunks(kh), to_chunks(vh), ig_c, cum_f))
    hn = head_layer_norm(from_chunks(hc), gn_g)
    hs = (hn + skip.astype(f32) * xc.astype(f32)) * jax.nn.silu(z.astype(f32))
    return hs.astype(u.dtype) @ w_out


def swiglu(u, w_gate, w_up, w_down):
    return (jax.nn.silu(u @ w_gate) * (u @ w_up)) @ w_down


def setup_inputs(seed: int = 0) -> dict:
    key = jax.random.key(seed)
    ks = jax.random.split(key, 24)

    def nrm(k, shape, scale):
        return jax.random.normal(k, shape, jnp.float32) * scale

    x = jax.random.normal(ks[0], (BATCH, SEQ, D_MODEL), jnp.float32)
    positions = jnp.broadcast_to(jnp.arange(SEQ, dtype=jnp.int32), (BATCH, SEQ))
    norm_mix_g = 1.0 + nrm(ks[1], (DEPTH, D_MODEL), 0.02)
    norm_ffn_g = 1.0 + nrm(ks[2], (DEPTH, D_MODEL), 0.02)
    ret_w_in = nrm(ks[3], (N_RET_LAYERS, D_MODEL, RET_IN_DIM), D_MODEL ** -0.5)
    ret_gn_g = 1.0 + nrm(ks[4], (N_RET_LAYERS, RET_V_DIM), 0.02)
    ret_w_out = nrm(ks[5], (N_RET_LAYERS, RET_V_DIM, D_MODEL), RET_V_DIM ** -0.5)
    ml_w_in = nrm(ks[6], (N_ML_LAYERS, D_MODEL, 2 * ML_INNER), D_MODEL ** -0.5)
    ml_conv_w = nrm(ks[7], (N_ML_LAYERS, CONV_WIDTH, ML_INNER), CONV_WIDTH ** -0.5)
    ml_conv_b = nrm(ks[8], (N_ML_LAYERS, ML_INNER), 0.01)
    ml_w_q = nrm(ks[9], (N_ML_LAYERS, N_QKV_BLOCKS, QKV_BLOCK, QKV_BLOCK), QKV_BLOCK ** -0.5)
    ml_w_k = nrm(ks[10], (N_ML_LAYERS, N_QKV_BLOCKS, QKV_BLOCK, QKV_BLOCK), QKV_BLOCK ** -0.5)
    ml_w_v = nrm(ks[11], (N_ML_LAYERS, N_QKV_BLOCKS, QKV_BLOCK, QKV_BLOCK), QKV_BLOCK ** -0.5)
    ml_w_gate = nrm(ks[12], (N_ML_LAYERS, 3 * ML_INNER, 2 * ML_HEADS), (3 * ML_INNER) ** -0.5)
    ig_bias = nrm(ks[13], (N_ML_LAYERS, ML_HEADS), 0.1)
    fg_bias = jnp.linspace(3.0, 6.0, ML_HEADS, dtype=jnp.float32)[None] + nrm(ks[14], (N_ML_LAYERS, ML_HEADS), 0.01)
    ml_b_gate = jnp.concatenate([ig_bias, fg_bias], axis=-1)
    ml_gn_g = 1.0 + nrm(ks[15], (N_ML_LAYERS, ML_INNER), 0.02)
    ml_skip = 1.0 + nrm(ks[16], (N_ML_LAYERS, ML_INNER), 0.02)
    ml_w_out = nrm(ks[17], (N_ML_LAYERS, ML_INNER, D_MODEL), ML_INNER ** -0.5)
    ffn_w_gate = nrm(ks[18], (DEPTH, D_MODEL, D_FF), D_MODEL ** -0.5)
    ffn_w_up = nrm(ks[19], (DEPTH, D_MODEL, D_FF), D_MODEL ** -0.5)
    ffn_w_down = nrm(ks[20], (DEPTH, D_FF, D_MODEL), D_FF ** -0.5)
    final_g = 1.0 + nrm(ks[21], (D_MODEL,), 0.02)
    return {'x': x, 'positions': positions, 'norm_mix_g': norm_mix_g, 'norm_ffn_g': norm_ffn_g,
            'ret_w_in': ret_w_in, 'ret_gn_g': ret_gn_g, 'ret_w_out': ret_w_out,
            'ml_w_in': ml_w_in, 'ml_conv_w': ml_conv_w, 'ml_conv_b': ml_conv_b,
            'ml_w_q': ml_w_q, 'ml_w_k': ml_w_k, 'ml_w_v': ml_w_v,
            'ml_w_gate': ml_w_gate, 'ml_b_gate': ml_b_gate, 'ml_gn_g': ml_gn_g,
            'ml_skip': ml_skip, 'ml_w_out': ml_w_out,
            'ffn_w_gate': ffn_w_gate, 'ffn_w_up': ffn_w_up, 'ffn_w_down': ffn_w_down,
            'final_g': final_g}


def reference(x, positions, norm_mix_g, norm_ffn_g, ret_w_in, ret_gn_g, ret_w_out,
              ml_w_in, ml_conv_w, ml_conv_b, ml_w_q, ml_w_k, ml_w_v, ml_w_gate, ml_b_gate,
              ml_gn_g, ml_skip, ml_w_out, ffn_w_gate, ffn_w_up, ffn_w_down, final_g):
    h = x
    for i in range(DEPTH):
        j = i // N_MIXERS
        u = rms_norm(h, norm_mix_g[i])
        if i % N_MIXERS == 0:
            h = h + retention_mixer(u, positions, ret_w_in[j], ret_gn_g[j], ret_w_out[j])
        else:
            h = h + mlstm_mixer(u, ml_w_in[j], ml_conv_w[j], ml_conv_b[j], ml_w_q[j], ml_w_k[j],
                                ml_w_v[j], ml_w_gate[j], ml_b_gate[j], ml_gn_g[j], ml_skip[j],
                                ml_w_out[j])
        u = rms_norm(h, norm_ffn_g[i])
        h = h + swiglu(u, ffn_w_gate[i], ffn_w_up[i], ffn_w_down[i])
    return rms_norm(h, final_g)
```

```cpp
#include <hip/hip_runtime.h>
#include <hip/hip_cooperative_groups.h>
#include <cstdio>
#include <cstdint>
namespace cg = cooperative_groups;

#define LAS __attribute__((address_space(3)))
typedef unsigned short bf16_t;
typedef short bf16x8 __attribute__((ext_vector_type(8)));
typedef short s16x4 __attribute__((ext_vector_type(4)));
typedef float f32x4 __attribute__((ext_vector_type(4)));
typedef float f32x2 __attribute__((ext_vector_type(2)));
typedef float f32x16 __attribute__((ext_vector_type(16)));
typedef unsigned u32x4 __attribute__((ext_vector_type(4)));
typedef unsigned u32x2 __attribute__((ext_vector_type(2)));
typedef __bf16 bf16x2_t __attribute__((ext_vector_type(2)));

constexpr int T = 32768, DM = 2048, FF = 5632, NCB = 256;
constexpr float EPSN = 1e-6f;
constexpr size_t MiB = 1u << 20;
constexpr size_t WS_SUMSQ = 6 * MiB;
constexpr size_t WS_MISC = 1 * MiB;
constexpr size_t WS_BDQ = WS_MISC;
constexpr size_t WS_BDK = WS_BDQ + 262144;
constexpr size_t WS_IDT = WS_BDK + 262144;
constexpr size_t WS_WGC = WS_IDT + 4096;
constexpr size_t WS_WGM = WS_WGC + 131072;
constexpr size_t WS_GA = WS_WGM + 131072;
constexpr size_t WS_GPM = WS_GA + 524288;
constexpr size_t WS_GB = WS_GPM + 524288;
constexpr size_t WS_DENA = WS_GB + 524288;
constexpr size_t WS_DENI = WS_DENA + 524288;
constexpr size_t WS_EMT = WS_DENI + 524288;
constexpr size_t WS_BLAST = WS_EMT + 524288;
constexpr size_t WS_PML = WS_BLAST + 4096;
constexpr size_t WS_DEC = WS_PML + 4096;
constexpr size_t WS_CW = WS_DEC + 4096;
constexpr size_t WS_BDQC = 5 * MiB + 512 * 1024;
constexpr size_t WS_BDKC = WS_BDQC + 32768;
static_assert(WS_CW + 524288 <= WS_BDQC && WS_BDKC + 32768 <= 6 * MiB, "misc");
constexpr size_t WS_BAR = 7 * MiB + 512 * 1024;
constexpr size_t WS_RA = 8 * MiB;
constexpr size_t WS_RB = 136 * MiB;
constexpr size_t WS_RC = 904 * MiB;
constexpr size_t WS_END = 1024 * MiB;
constexpr size_t WS_Q = WS_RB, WS_K = WS_RB + 128 * MiB, WS_V = WS_RB + 256 * MiB, WS_G = WS_RB + 512 * MiB;
constexpr size_t WS_Y = WS_RB;
constexpr size_t WS_ACT0 = WS_RB + 256 * MiB;
constexpr size_t WS_WT2 = WS_RC, WS_WT3 = WS_RC + 16 * MiB, WS_WT4 = WS_RC + 60 * MiB;
constexpr size_t WS_WT5 = WS_RB + 608 * MiB;
constexpr size_t WS_XM = WS_RB, WS_Z = WS_RB + 256 * MiB, WS_XC = WS_RB + 512 * MiB;
constexpr size_t WS_PML1 = WS_RA;
constexpr size_t WS_KW = WS_RA + 32 * MiB;
constexpr size_t WS_NPREV = WS_RA + 36 * MiB;
constexpr size_t WS_INTER2 = WS_RA + 40 * MiB;
constexpr size_t WS_WT6 = WS_RC, WS_WT7 = WS_RC + 16 * MiB, WS_WT8 = WS_RC + 60 * MiB;
constexpr size_t WS_ACT1 = WS_RB;
constexpr size_t DO_WT1 = 0, DO_CS = 48 * MiB, DO_P0 = 80 * MiB;
constexpr size_t DO_PML1 = 0, DO_KW = 32 * MiB, DO_NPREV = 36 * MiB, DO_INTER2 = 40 * MiB;

struct Params {
    const float* in[22];
    float* out;
    unsigned char* ws;
    int ph_lo, ph_hi;
};

__device__ __forceinline__ unsigned pk2(float lo, float hi) { f32x2 v = {lo, hi}; return __builtin_bit_cast(unsigned, __builtin_convertvector(v, bf16x2_t)); }
__device__ __forceinline__ float bflo(unsigned u) { return __uint_as_float(u << 16); }
__device__ __forceinline__ float bfhi(unsigned u) { return __uint_as_float(u & 0xffff0000u); }
__device__ __forceinline__ void unpack8(const u32x4 v, float (&f)[8]) { f[0] = bflo(v.x); f[1] = bfhi(v.x); f[2] = bflo(v.y); f[3] = bfhi(v.y); f[4] = bflo(v.z); f[5] = bfhi(v.z); f[6] = bflo(v.w); f[7] = bfhi(v.w); }
__device__ __forceinline__ u32x4 pack8f(const float (&f)[8]) { u32x4 o; o.x = pk2(f[0], f[1]); o.y = pk2(f[2], f[3]); o.z = pk2(f[4], f[5]); o.w = pk2(f[6], f[7]); return o; }
__device__ __forceinline__ float wave_sum(float v) {
#pragma unroll
    for (int o = 1; o < 64; o <<= 1) v += __shfl_xor(v, o);
    return v;
}
typedef unsigned long long u64;
__device__ __forceinline__ u64 ss_fix(float s) { return (u64)((double)s * 16777216.0); }
__device__ __forceinline__ float ss_rstd(const u64* p, int row) { return rsqrtf((float)((double)p[row] * (1.0 / 16777216.0 / 2048.0)) + EPSN); }
__device__ __forceinline__ float silu_f(float x) { return x * __frcp_rn(1.0f + __expf(-x)); }
#define LDS_WAIT() asm volatile("s_waitcnt lgkmcnt(0)" ::: "memory")
__device__ __forceinline__ int crow(int i, int h) { return (i & 3) + 8 * (i >> 2) + 4 * h; }
__device__ __forceinline__ bf16x8 pack16(const f32x16& x, const int s) {
    u32x4 p; p.x = pk2(x[8 * s], x[8 * s + 1]); p.y = pk2(x[8 * s + 2], x[8 * s + 3]); p.z = pk2(x[8 * s + 4], x[8 * s + 5]); p.w = pk2(x[8 * s + 6], x[8 * s + 7]);
    return __builtin_bit_cast(bf16x8, p);
}
#define MFMA32(a, b, c) __builtin_amdgcn_mfma_f32_32x32x16_bf16((a), (b), (c), 0, 0, 0)
__device__ __forceinline__ bf16x8 ldg16(const bf16_t* p) { return *(const bf16x8*)p; }
__device__ __forceinline__ void lds_add(LAS float* p, float v) { (void)__hip_atomic_fetch_add(p, v, __ATOMIC_RELAXED, __HIP_MEMORY_SCOPE_WORKGROUP); }
__device__ __forceinline__ void lds_add_i(LAS int* p, int v) { (void)__hip_atomic_fetch_add(p, v, __ATOMIC_RELAXED, __HIP_MEMORY_SCOPE_WORKGROUP); }
constexpr float OFIX = 262144.0f, OFIX_INV = 1.0f / 262144.0f;

namespace pg8 {
constexpr int BM = 256, BK = 64, HALF = 128, HTB = HALF * BK * 2, STAGE_BYTES = 8 * HTB, NXCD = 8, WGM = 8;
__host__ __device__ __forceinline__ int lds_byte(int r, int c) { const int st = (r >> 4) * 2 + (c >> 5), rr = r & 15, cc = c & 31, ob = rr * 64 + cc * 2; return st * 1024 + (ob ^ (((ob >> 9) & 1) << 5)); }
__host__ __device__ __forceinline__ void stage_rc(int b, int& R, int& C) { const int st = b / 1024, sb = b % 1024, swz = sb ^ (((sb >> 9) & 1) << 5); R = (st >> 1) * 16 + swz / 64; C = (st & 1) * 32 + (swz % 64) / 2; }
__host__ __device__ __forceinline__ int perm32(int rho) { const int n = rho >> 4, i = rho & 15; return 8 * (i >> 2) + 4 * n + (i & 3); }
struct Unit { int pm, pn; };
struct Gemm { const bf16_t* A; const bf16_t* Bt; int M, N, K; };
struct StaticOrder {
    int nM, nN, nwg, G, c;
    __device__ void init(int M, int N, int G_, int c_) { nM = M / BM; nN = N / BM; nwg = nM * nN; G = G_; c = c_; }
    __device__ bool next(int i, Unit& u) const {
        const long L = (long)i * G + c; if (L >= nwg) return false;
        int wgid = (int)L; { const int q = nwg / NXCD, r = nwg % NXCD, xcd = wgid % NXCD, off = wgid / NXCD; wgid = (xcd < r ? xcd * (q + 1) : r * (q + 1) + (xcd - r) * q) + off; }
        const int nig = WGM * nN, gid = wgid / nig, fm = gid * WGM, gsz = (nM - fm) < WGM ? (nM - fm) : WGM;
        u.pm = fm + ((wgid % nig) % gsz); u.pn = (wgid % nig) / gsz; return true;
    }
};
template <class Epi>
__device__ __forceinline__ void gemm_phase(LAS unsigned char* lds, const Gemm g, const StaticOrder& S, const Epi& E) {
    const int tid = threadIdx.x, wid = __builtin_amdgcn_readfirstlane(tid >> 6), lane = tid & 63, wr = wid >> 2, wc = wid & 3, fr = lane & 15, fq = lane >> 4;
    const int K = g.K, nt = K / BK;
    unsigned voffA[2], voffB[2];
#pragma unroll
    for (int i = 0; i < 2; ++i) { int R, C; stage_rc(tid * 16 + i * 8192, R, C); const int Rb = Epi::PERM ? ((R & ~31) + perm32(R & 31)) : R;
        voffA[i] = (unsigned)(R * K + C) * 2u; voffB[i] = (unsigned)(Rb * K + C) * 2u; }
    const size_t kstep = (size_t)(BK * 2);
    const size_t hstep = (size_t)HALF * K * 2;
    const size_t tstep = 2 * hstep;
    const unsigned ldsw = (unsigned)wid * 1024u;
    const int aoff = lds_byte(wr * 64 + fr, fq * 8), boff = lds_byte(wc * 32 + fr, fq * 8);
#define PG8_SA(b, h) (((b) * 2 + (h)) * HTB)
#define PG8_SB(b, h) ((4 + (b) * 2 + (h)) * HTB)
#define PG8_STAGE(bufoff, gbase, voff) do { _Pragma("unroll") for (int _i = 0; _i < 2; ++_i) \
        __builtin_amdgcn_global_load_lds((const unsigned*)((const char*)(gbase) + (voff)[_i]), (LAS unsigned*)(lds + (bufoff) + ldsw + _i * 8192), 16, 0, 0); } while (0)
#define PG8_LDA(dst, b, h) do { _Pragma("unroll") for (int m = 0; m < 4; ++m) _Pragma("unroll") for (int k = 0; k < 2; ++k) dst[m][k] = *(const LAS bf16x8*)(lds + PG8_SA(b, h) + aoff + m * 2048 + k * 1024); } while (0)
#define PG8_LDB(dst, b, h) do { _Pragma("unroll") for (int n = 0; n < 2; ++n) _Pragma("unroll") for (int k = 0; k < 2; ++k) dst[n][k] = *(const LAS bf16x8*)(lds + PG8_SB(b, h) + boff + n * 2048 + k * 1024); } while (0)
#define PG8_MMA(ai, bj, At, Bt) do { __builtin_amdgcn_s_setprio(1); _Pragma("unroll") for (int m = 0; m < 4; ++m) _Pragma("unroll") for (int n = 0; n < 2; ++n) _Pragma("unroll") for (int k = 0; k < 2; ++k) \
        acc[ai][bj][m][n] = __builtin_amdgcn_mfma_f32_16x16x32_bf16(Bt[n][k], At[m][k], acc[ai][bj][m][n], 0, 0, 0); __builtin_amdgcn_s_setprio(0); } while (0)
#define PG8_WAIT_V(n) asm volatile("s_waitcnt vmcnt(" #n ")" ::: "memory")
#define PG8_WAIT_L(n) asm volatile("s_waitcnt lgkmcnt(" #n ")" ::: "memory")
#define PG8_BAR __builtin_amdgcn_s_barrier()
#define PG8_SCHED __builtin_amdgcn_sched_barrier(0)
    Unit cur, nxt; int ui = 0;
    if (!S.next(0, cur)) return;
    f32x4 acc[2][2][4][2];
#pragma unroll
    for (int a = 0; a < 2; ++a)
#pragma unroll
        for (int b = 0; b < 2; ++b)
#pragma unroll
            for (int m = 0; m < 4; ++m)
#pragma unroll
                for (int n = 0; n < 2; ++n) acc[a][b][m][n] = (f32x4){0.f, 0.f, 0.f, 0.f};
    bf16x8 At[4][2], B0[2][2], B1[2][2];
    const char* cA = (const char*)g.A + (size_t)cur.pm * tstep; const char* cB = (const char*)g.Bt + (size_t)cur.pn * tstep;
    PG8_STAGE(PG8_SB(0, 0), cB, voffB); PG8_STAGE(PG8_SB(0, 1), cB + hstep, voffB); PG8_STAGE(PG8_SA(0, 0), cA, voffA); PG8_STAGE(PG8_SA(0, 1), cA + hstep, voffA);
    if (wr == 1) PG8_BAR;
    PG8_WAIT_V(2); PG8_BAR;
    PG8_STAGE(PG8_SB(1, 0), cB + kstep, voffB); PG8_STAGE(PG8_SA(1, 0), cA + kstep, voffA); PG8_STAGE(PG8_SB(1, 1), cB + hstep + kstep, voffB);
    PG8_WAIT_V(6); PG8_BAR;
    for (;;) {
        const bool has_next = S.next(ui + 1, nxt);
        const char* nA = has_next ? (const char*)g.A + (size_t)nxt.pm * tstep : cA; const char* nB = has_next ? (const char*)g.Bt + (size_t)nxt.pn * tstep : cB;
        for (int t = 0; t < nt; t += 2) {
            const bool last = (t == nt - 2);
            const char* a1 = cA + (size_t)(t + 1) * kstep;
            const char* a2 = last ? nA : cA + (size_t)(t + 2) * kstep; const char* b2 = last ? nB : cB + (size_t)(t + 2) * kstep;
            const char* a3 = a2 + kstep; const char* b3 = b2 + kstep;
            PG8_LDB(B0, 0, 0); PG8_LDB(B1, 0, 1); PG8_SCHED; PG8_LDA(At, 0, 0); PG8_STAGE(PG8_SA(1, 1), a1 + hstep, voffA);
            PG8_WAIT_V(8); PG8_WAIT_L(0); PG8_BAR; PG8_MMA(0, 0, At, B0); PG8_MMA(0, 1, At, B1); PG8_BAR; PG8_SCHED;
            PG8_LDA(At, 0, 1); PG8_STAGE(PG8_SB(0, 0), b2, voffB); PG8_STAGE(PG8_SB(0, 1), b2 + hstep, voffB); PG8_STAGE(PG8_SA(0, 0), a2, voffA);
            PG8_WAIT_V(8); PG8_WAIT_L(0); PG8_BAR; PG8_MMA(1, 0, At, B0); PG8_MMA(1, 1, At, B1); PG8_BAR; PG8_SCHED;
            PG8_LDB(B0, 1, 0); PG8_LDB(B1, 1, 1); PG8_SCHED; PG8_LDA(At, 1, 0); PG8_STAGE(PG8_SA(0, 1), a2 + hstep, voffA);
            PG8_WAIT_V(8); PG8_WAIT_L(0); PG8_BAR; PG8_MMA(0, 0, At, B0); PG8_MMA(0, 1, At, B1); PG8_BAR; PG8_SCHED;
            PG8_LDA(At, 1, 1); PG8_STAGE(PG8_SB(1, 0), b3, voffB); PG8_STAGE(PG8_SB(1, 1), b3 + hstep, voffB); PG8_STAGE(PG8_SA(1, 0), a3, voffA);
            PG8_WAIT_V(8); PG8_WAIT_L(0); PG8_BAR; PG8_MMA(1, 0, At, B0); PG8_MMA(1, 1, At, B1); PG8_BAR; PG8_SCHED;
        }
        if (wr == 0) PG8_BAR;
        E(acc, cur, wr, wc, fr, fq);
        if (!has_next) break;
#pragma unroll
        for (int a = 0; a < 2; ++a)
#pragma unroll
            for (int b = 0; b < 2; ++b)
#pragma unroll
                for (int m = 0; m < 4; ++m)
#pragma unroll
                    for (int n = 0; n < 2; ++n) acc[a][b][m][n] = (f32x4){0.f, 0.f, 0.f, 0.f};
        cur = nxt; cA = nA; cB = nB; ++ui;
        if (wr == 1) PG8_BAR;
    }
    PG8_WAIT_V(0);
    PG8_BAR;
#undef PG8_SA
#undef PG8_SB
#undef PG8_STAGE
#undef PG8_LDA
#undef PG8_LDB
#undef PG8_MMA
#undef PG8_WAIT_V
#undef PG8_WAIT_L
#undef PG8_BAR
#undef PG8_SCHED
}
}
using pg8::Unit;
typedef const f32x4 (&AccRef)[2][2][4][2];

struct EpiRetIn {
    static constexpr bool PERM = true;
    bf16_t *Q, *K, *V, *G; const u64* sumsq; const float* cs;
    __device__ __forceinline__ void operator()(AccRef acc, const Unit& u, int wr, int wc, int fr, int fq) const {
        const int row0 = u.pm * 256 + wr * 64 + fr, pn = u.pn;
        bf16_t* base; int ldc, colt; bool rope = false; float sc = 1.f;
        if (pn < 8) { base = Q; ldc = 2048; colt = pn * 256; rope = true; }
        else if (pn < 16) { base = K; ldc = 2048; colt = (pn - 8) * 256; rope = true; sc = 0.0625f; }
        else if (pn < 32) { base = V; ldc = 4096; colt = (pn - 16) * 256; }
        else { base = G; ldc = 4096; colt = (pn - 32) * 256; }
        const int i0 = wc * 32 + 8 * fq, col0 = colt + i0;
        u64 sq[2][4];
#pragma unroll
        for (int ai = 0; ai < 2; ++ai)
#pragma unroll
            for (int m = 0; m < 4; ++m) sq[ai][m] = sumsq[row0 + ai * 128 + m * 16];
#pragma unroll
        for (int ai = 0; ai < 2; ++ai)
#pragma unroll
            for (int m = 0; m < 4; ++m) {
                const int row = row0 + ai * 128 + m * 16;
                const float rs = ss_rstd(&sq[ai][m], 0) * sc;
                f32x4 a0 = acc[ai][0][m][0] * rs, a1 = acc[ai][0][m][1] * rs, b0 = acc[ai][1][m][0] * rs, b1 = acc[ai][1][m][1] * rs;
                if (rope) {
                    const f32x4* cp = (const f32x4*)(cs + ((size_t)row * 128 + i0) * 2);
                    const f32x4 c01 = cp[0], c23 = cp[1], c45 = cp[2], c67 = cp[3];
                    f32x4 o0, o1, p0, p1;
                    o0[0] = a0[0] * c01[0] - b0[0] * c01[1]; p0[0] = a0[0] * c01[1] + b0[0] * c01[0];
                    o0[1] = a0[1] * c01[2] - b0[1] * c01[3]; p0[1] = a0[1] * c01[3] + b0[1] * c01[2];
                    o0[2] = a0[2] * c23[0] - b0[2] * c23[1]; p0[2] = a0[2] * c23[1] + b0[2] * c23[0];
                    o0[3] = a0[3] * c23[2] - b0[3] * c23[3]; p0[3] = a0[3] * c23[3] + b0[3] * c23[2];
                    o1[0] = a1[0] * c45[0] - b1[0] * c45[1]; p1[0] = a1[0] * c45[1] + b1[0] * c45[0];
                    o1[1] = a1[1] * c45[2] - b1[1] * c45[3]; p1[1] = a1[1] * c45[3] + b1[1] * c45[2];
                    o1[2] = a1[2] * c67[0] - b1[2] * c67[1]; p1[2] = a1[2] * c67[1] + b1[2] * c67[0];
                    o1[3] = a1[3] * c67[2] - b1[3] * c67[3]; p1[3] = a1[3] * c67[3] + b1[3] * c67[2];
                    a0 = o0; a1 = o1; b0 = p0; b1 = p1;
                }
                bf16_t* rowp = base + (size_t)row * ldc + col0;
                u32x4 w; w.x = pk2(a0[0], a0[1]); w.y = pk2(a0[2], a0[3]); w.z = pk2(a1[0], a1[1]); w.w = pk2(a1[2], a1[3]);
                *(u32x4*)rowp = w;
                w.x = pk2(b0[0], b0[1]); w.y = pk2(b0[2], b0[3]); w.z = pk2(b1[0], b1[1]); w.w = pk2(b1[2], b1[3]);
                *(u32x4*)(rowp + 128) = w;
            }
    }
};
struct EpiResid {
    static constexpr bool PERM = true;
    bf16_t* hb; u64* sumsq;
    __device__ __forceinline__ void operator()(AccRef acc, const Unit& u, int wr, int wc, int fr, int fq) const {
        const int row0 = u.pm * 256 + wr * 64 + fr, col0 = u.pn * 256 + wc * 32 + 8 * fq;
#pragma unroll
        for (int ai = 0; ai < 2; ++ai) {
            u32x4 pre[4][2];
#pragma unroll
            for (int m = 0; m < 4; ++m)
#pragma unroll
                for (int bj = 0; bj < 2; ++bj) pre[m][bj] = *(const u32x4*)(hb + (size_t)(row0 + ai * 128 + m * 16) * DM + col0 + bj * 128);
#pragma unroll
            for (int m = 0; m < 4; ++m) {
                const int row = row0 + ai * 128 + m * 16; const size_t off = (size_t)row * DM + col0; float ss = 0.f;
#pragma unroll
                for (int bj = 0; bj < 2; ++bj) {
                    float o[8]; unpack8(pre[m][bj], o);
#pragma unroll
                    for (int j = 0; j < 4; ++j) { o[j] += acc[ai][bj][m][0][j]; o[4 + j] += acc[ai][bj][m][1][j]; }
#pragma unroll
                    for (int j = 0; j < 8; ++j) ss += o[j] * o[j];
                    *(u32x4*)(hb + off + bj * 128) = pack8f(o);
                }
                ss += __shfl_xor(ss, 16); ss += __shfl_xor(ss, 32);
                if (sumsq && fq == 0) atomicAdd(sumsq + row, ss_fix(ss));
            }
        }
    }
};
struct EpiSwiGLU {
    static constexpr bool PERM = true;
    bf16_t* O; const u64* sumsq;
    __device__ __forceinline__ void operator()(AccRef acc, const Unit& u, int wr, int wc, int fr, int fq) const {
        const int row0 = u.pm * 256 + wr * 64 + fr, col0 = u.pn * 128 + wc * 32 + 8 * fq;
        u64 sq[2][4];
#pragma unroll
        for (int ai = 0; ai < 2; ++ai)
#pragma unroll
            for (int m = 0; m < 4; ++m) sq[ai][m] = sumsq[row0 + ai * 128 + m * 16];
#pragma unroll
        for (int ai = 0; ai < 2; ++ai)
#pragma unroll
            for (int m = 0; m < 4; ++m) {
                const int row = row0 + ai * 128 + m * 16;
                const float rs = ss_rstd(&sq[ai][m], 0);
                float o[8];
#pragma unroll
                for (int n = 0; n < 2; ++n)
#pragma unroll
                    for (int j = 0; j < 4; ++j) { const float g = acc[ai][0][m][n][j] * rs, up = acc[ai][1][m][n][j] * rs; o[4 * n + j] = silu_f(g) * up; }
                *(u32x4*)(O + (size_t)row * FF + col0) = pack8f(o);
            }
    }
};
struct EpiMlIn {
    static constexpr bool PERM = true;
    bf16_t *XM, *Z; const u64* sumsq;
    __device__ __forceinline__ void operator()(AccRef acc, const Unit& u, int wr, int wc, int fr, int fq) const {
        const int row0 = u.pm * 256 + wr * 64 + fr, pn = u.pn;
        bf16_t* base = pn < 16 ? XM : Z; const int col0 = (pn & 15) * 256 + wc * 32 + 8 * fq;
        u64 sq[2][4];
#pragma unroll
        for (int ai = 0; ai < 2; ++ai)
#pragma unroll
            for (int m = 0; m < 4; ++m) sq[ai][m] = sumsq[row0 + ai * 128 + m * 16];
#pragma unroll
        for (int ai = 0; ai < 2; ++ai)
#pragma unroll
            for (int m = 0; m < 4; ++m) {
                const int row = row0 + ai * 128 + m * 16;
                const float rs = ss_rstd(&sq[ai][m], 0);
                bf16_t* rowp = base + (size_t)row * 4096 + col0;
#pragma unroll
                for (int bj = 0; bj < 2; ++bj) {
                    const f32x4 v0 = acc[ai][bj][m][0] * rs, v1 = acc[ai][bj][m][1] * rs;
                    u32x4 w; w.x = pk2(v0[0], v0[1]); w.y = pk2(v0[2], v0[3]); w.z = pk2(v1[0], v1[1]); w.w = pk2(v1[2], v1[3]);
                    *(u32x4*)(rowp + bj * 128) = w;
                }
            }
    }
};

__device__ __forceinline__ void convert_weight(const float* W, int K, int N, bf16_t* WT, const float* g, int mode, LAS float* scr, int gw, int ngw, int lane) {
    const int nblk = N / 32, nitems = (K / 64) * nblk;
    for (int it = gw; it < nitems; it += ngw) {
        const int kb = it / nblk, nb = it % nblk, k0 = 64 * kb, n0 = 32 * nb;
        const int orow0 = mode == 0 ? n0 : (256 * (n0 >> 7) + (n0 & 127) + (mode == 2 ? 128 : 0));
        {
            f32x4 wv4[8];
#pragma unroll
            for (int i = 0; i < 8; ++i) wv4[i] = *(const f32x4*)(W + (size_t)(k0 + 8 * i + (lane >> 3)) * N + n0 + 4 * (lane & 7));
#pragma unroll
            for (int i = 0; i < 8; ++i) { const int kk = 8 * i + (lane >> 3); const float gs = g ? g[k0 + kk] : 1.0f; LAS float* d = scr + kk * 33 + 4 * (lane & 7);
                d[0] = wv4[i][0] * gs; d[1] = wv4[i][1] * gs; d[2] = wv4[i][2] * gs; d[3] = wv4[i][3] * gs; }
        }
        LDS_WAIT(); asm volatile("" ::: "memory");
        const int c = lane & 7;
#pragma unroll
        for (int j = 0; j < 4; ++j) { const int n = (lane >> 3) + 8 * j; const LAS float* s = scr + (8 * c) * 33 + n;
            u32x4 o; o.x = pk2(s[0 * 33], s[1 * 33]); o.y = pk2(s[2 * 33], s[3 * 33]); o.z = pk2(s[4 * 33], s[5 * 33]); o.w = pk2(s[6 * 33], s[7 * 33]);
            *(u32x4*)(WT + (size_t)(orow0 + n) * K + k0 + 8 * c) = o; }
        LDS_WAIT(); asm volatile("" ::: "memory");
    }
}

template <int NT, bool ML>
__device__ __forceinline__ void phase_scores(const bf16_t* XQ, const bf16_t* XK, int ldx, const bf16_t* IDT, const u32x2* WQC, const u32x2* WKC, int H, bf16_t* Pout,
                                             const float* GA, const float* GPM, const float* GB, const float* BLAST, const float* PML, float* DENA, float* EMT, float* INTER, float* INTER2, float* CW, float* DEC, float* KW, LAS unsigned char* lds) {
    const int tid = threadIdx.x, wave = __builtin_amdgcn_readfirstlane(tid >> 6), lane = tid & 63, r = lane & 31, hh = lane >> 5;
    LAS unsigned char* buf0 = lds; LAS unsigned char* buf1 = lds + 65536;
    LAS float* l_bl = (LAS float*)(lds + 131072);
    LAS float* l_pl = l_bl + 128;
    LAS float* l_pm = l_pl + 128;
    LAS float* l_rs = l_pm + 128;
    LAS float* l_mp = l_rs + 128;
    LAS float* l_cw = l_mp + 4;
    const int tt = wave >> 1, par = wave & 1;
    const int st0 = par, st1 = par + 2;
    const bool v0 = ML ? st0 <= tt : st0 == tt, v1 = ML ? st1 <= tt : st1 == tt;
    const int bdsel = (hh == ((r >> 3) & 1)) ? ((r >> 4) * 2 + ((r >> 2) & 1)) : -1;
#define BDFRAG(v, ks) __builtin_bit_cast(bf16x8, (u32x4){bdsel == 2 * (ks) ? (v).x : 0u, bdsel == 2 * (ks) ? (v).y : 0u, bdsel == 2 * (ks) + 1 ? (v).x : 0u, bdsel == 2 * (ks) + 1 ? (v).y : 0u})
#define P_ISSUE(bufp, gp) do { _Pragma("unroll") for (int j_ = 0; j_ < 8; ++j_) \
        __builtin_amdgcn_global_load_lds((const unsigned*)((gp) + (size_t)j_ * 16 * ldx), (LAS unsigned*)((bufp) + j_ * 8192 + wave * 1024), 16, 0, 0); } while (0)
#define P_FRAG(bufp, tile, c) (*(const LAS bf16x8*)((bufp) + (32 * (tile) + r) * 512 + ((((c)) ^ (r & 15)) * 16)))
    const int dsl = (tid & 31) ^ ((tid >> 5) & 15);
    const bf16x8 iw0 = ML ? (bf16x8){0, 0, 0, 0, 0, 0, 0, 0} : ldg16(IDT + r * 32 + 8 * hh), iw1 = ML ? (bf16x8){0, 0, 0, 0, 0, 0, 0, 0} : ldg16(IDT + r * 32 + 8 * hh + 16);
    constexpr int NSTEP = ML ? NT / 8 : 1;
    for (int unit = blockIdx.x; unit < NCB * H; unit += gridDim.x) {
        const int cb = unit / H, h = unit % H, row0 = cb * 128, nprev = cb & 127;
        const bf16_t* xqg = XQ + (size_t)(row0 + (tid >> 5)) * ldx + h * (32 * NT) + dsl * 8;
        const bf16_t* xkg = XK + (size_t)(row0 + (tid >> 5)) * ldx + h * (32 * NT) + dsl * 8;
        P_ISSUE(buf0, xqg); if (!ML) P_ISSUE(buf1, xkg);
        float m_prev = 0.f;
        if (ML) {
            if (tid < 128) { l_rs[tid] = 0.f; l_pm[tid] = GPM[(size_t)(row0 + tid) * 4 + h];
                if (tid < nprev) { l_bl[tid] = BLAST[(cb - nprev + tid) * 4 + h]; l_pl[tid] = PML[(cb - nprev + tid) * 4 + h]; } }
            __syncthreads();
            if (tid == 0) { float m = 0.f; for (int c = 0; c < nprev; ++c) m = l_bl[c] + fmaxf(m, l_pl[c]); l_mp[0] = m; }
            __syncthreads();
            m_prev = l_mp[0];
            const float mlast = fmaxf(PML[cb * 4 + h], m_prev);
            if (tid < 128) { const size_t o = (size_t)(row0 + tid) * 4 + h; const float cwv = __expf(GA[o] - mlast); l_cw[tid] = cwv; CW[o] = cwv; const float Mt_ = fmaxf(l_pm[tid], m_prev); INTER[o] = __expf(m_prev - Mt_); INTER2[o] = __expf(mlast - Mt_); }
            if (tid == 0) DEC[cb * 4 + h] = __expf(m_prev - mlast);
        }
        f32x16 Z0, Z1, z;
#pragma unroll
        for (int i = 0; i < 16; ++i) { Z0[i] = 0.f; Z1[i] = 0.f; z[i] = 0.f; }
#pragma unroll 1
        for (int step = 0; step < NSTEP; ++step) {
            if (ML && step + 1 < NSTEP) { P_ISSUE(((step + 1) & 1) ? buf1 : buf0, xqg + (step + 1) * 256); asm volatile("s_waitcnt vmcnt(8)" ::: "memory"); }
            else asm volatile("s_waitcnt vmcnt(0)" ::: "memory");
            __syncthreads();
            LAS unsigned char* qb = ML ? ((step & 1) ? buf1 : buf0) : buf0; LAS unsigned char* kb = ML ? qb : buf1;
#pragma unroll 2
            for (int d = 0; d < 8; ++d) {
                bf16x8 wq0, wq1, wk0, wk1;
                if (ML) { const u32x2 qv = WQC[(size_t)(h * NT + step * 8 + d) * 32 + r], kv = WKC[(size_t)(h * NT + step * 8 + d) * 32 + r];
                    wq0 = BDFRAG(qv, 0); wq1 = BDFRAG(qv, 1); wk0 = BDFRAG(kv, 0); wk1 = BDFRAG(kv, 1); }
                else { wq0 = wk0 = iw0; wq1 = wk1 = iw1; }
                f32x16 qT = MFMA32(wq0, P_FRAG(qb, tt, 4 * d + hh), z); qT = MFMA32(wq1, P_FRAG(qb, tt, 4 * d + 2 + hh), qT);
                const bf16x8 qa0 = pack16(qT, 0), qa1 = pack16(qT, 1);
                if (v0) { f32x16 kT = MFMA32(wk0, P_FRAG(kb, st0, 4 * d + hh), z); kT = MFMA32(wk1, P_FRAG(kb, st0, 4 * d + 2 + hh), kT); Z0 = MFMA32(qa0, pack16(kT, 0), Z0); Z0 = MFMA32(qa1, pack16(kT, 1), Z0); }
                if (v1) { f32x16 kT = MFMA32(wk0, P_FRAG(kb, st1, 4 * d + hh), z); kT = MFMA32(wk1, P_FRAG(kb, st1, 4 * d + 2 + hh), kT); Z1 = MFMA32(qa0, pack16(kT, 0), Z1); Z1 = MFMA32(qa1, pack16(kT, 1), Z1); }
            }
            if (ML) {
                const int dkt = step * 8 + wave;
                const u32x2 kv = WKC[(size_t)(h * NT + dkt) * 32 + r];
                const bf16x8 wk0 = BDFRAG(kv, 0), wk1 = BDFRAG(kv, 1);
                bf16x8 ones;
#pragma unroll
                for (int j = 0; j < 8; ++j) ones[j] = (r == 0) ? (short)0x3f80 : (short)0;
                f32x16 Zk = z;
#pragma unroll
                for (int st = 0; st < 4; ++st) {
                    f32x16 kT = MFMA32(P_FRAG(kb, st, 4 * wave + hh), wk0, z); kT = MFMA32(P_FRAG(kb, st, 4 * wave + 2 + hh), wk1, kT);
#pragma unroll
                    for (int g4 = 0; g4 < 4; ++g4) { const f32x4 c4 = *(const LAS f32x4*)(l_cw + 32 * st + 8 * g4 + 4 * hh);
                        kT[4 * g4] *= c4[0]; kT[4 * g4 + 1] *= c4[1]; kT[4 * g4 + 2] *= c4[2]; kT[4 * g4 + 3] *= c4[3]; }
                    Zk = MFMA32(pack16(kT, 0), ones, Zk); Zk = MFMA32(pack16(kT, 1), ones, Zk);
                }
                if (r == 0) {
#pragma unroll
                    for (int i = 0; i < 16; ++i) KW[(size_t)(cb * 4 + h) * 1024 + 32 * dkt + crow(i, hh)] = Zk[i];
                }
            }
            __syncthreads();
        }
        float rsum[16];
#pragma unroll
        for (int i = 0; i < 16; ++i) rsum[i] = 0.f;
        const float l2g = ML ? 0.f : (float)(log1p(-exp2((double)(-5 - h))) * 1.4426950408889634);
#pragma unroll
        for (int k = 0; k < 2; ++k) {
            const bool vv = k ? v1 : v0; const int st = k ? st1 : st0;
            if (vv) {
                const int s = 32 * st + r;
                const float a_s = ML ? GA[(size_t)(row0 + s) * 4 + h] : 0.f;
#pragma unroll
                for (int i = 0; i < 16; ++i) {
                    const int t = 32 * tt + crow(i, hh);
                    float f;
                    if (ML) { const float Mt = fmaxf(l_pm[t], m_prev); f = __expf(a_s - Mt); } else f = exp2f((float)(t - s) * l2g);
                    const float raw = (t >= s) ? (k ? Z1[i] : Z0[i]) : 0.f;
                    rsum[i] += raw * f;
                    if (st == tt) Pout[((size_t)(row0 + t) * H + h) * 128 + s] = (bf16_t)(pk2(raw, 0.f) & 0xffffu);
                }
            }
        }
        if (ML) {
#pragma unroll
            for (int i = 0; i < 16; ++i) { float v = rsum[i]; v += __shfl_xor(v, 1); v += __shfl_xor(v, 2); v += __shfl_xor(v, 4); v += __shfl_xor(v, 8); v += __shfl_xor(v, 16);
                if (r == 0) lds_add(&l_rs[32 * tt + crow(i, hh)], v); }
            __syncthreads();
            if (tid < 128) { const size_t o = (size_t)(row0 + tid) * 4 + h; DENA[o] = l_rs[tid]; EMT[o] = __expf(-(GB[o] + fmaxf(l_pm[tid], m_prev))); }
            __syncthreads();
        }
    }
#undef BDFRAG
#undef P_ISSUE
#undef P_FRAG
}

template <int NP, bool ML>
__device__ __forceinline__ void phase_scan(const bf16_t* XQ, const bf16_t* XK, int ldx, const bf16_t* WQ, const bf16_t* WK, int H, int dv, bf16_t* VO, const bf16_t* P,
                                           const float* WV, const float* INTER, const float* INTER2, const float* CW, const float* DEC, LAS unsigned char* lds, bool do_store = true) {
    constexpr int NT = 8 * NP, VP = 136;
    constexpr int NST = 3;
    const int tid = threadIdx.x, wave = __builtin_amdgcn_readfirstlane(tid >> 6), lane = tid & 63, r = lane & 31, hh = lane >> 5;
    LAS bf16_t* l_vw = (LAS bf16_t*)lds;
    LAS int* l_os = (LAS int*)(lds + 32 * VP * 2);
    LAS float* l_wv = (LAS float*)(l_os + 128 * 33);
    constexpr int SS = ML ? 2048 : 4096;
    constexpr int NU = 2;
    LAS unsigned char* l_ring = (LAS unsigned char*)(l_wv + 128) + wave * (ML ? NU * 4096 : NST * SS);
    LAS unsigned char* l_pbr = (LAS unsigned char*)(l_wv + 128) + 8 * (ML ? NU * 4096 : NST * SS) + wave * 2560;
    const int nbh = 2 * H, per_xcd = nbh / 8;
    const int bdsel = (hh == ((r >> 3) & 1)) ? ((r >> 4) * 2 + ((r >> 2) & 1)) : -1;
    for (int unit = blockIdx.x; unit < 256; unit += gridDim.x) {
        const int xcd = unit & 7, vq = unit >> 3, bh = xcd * per_xcd + vq % per_xcd, slice = vq / per_xcd;
        const int b = bh / H, h = bh % H, vcol = h * dv + slice * 32, qcol = h * (32 * NT);
        for (int i = tid; i < 128 * 33; i += 512) l_os[i] = 0;
        if (ML && tid < 128) l_wv[tid] = WV[(size_t)(vcol / 4) * 16 + tid];
        f32x16 S[NP];
#pragma unroll
        for (int p = 0; p < NP; ++p) {
#pragma unroll
            for (int i = 0; i < 16; ++i) S[p][i] = 0.f; }
        const int vs = tid >> 2, vc8 = tid & 3;
        const float l2g = ML ? 0.f : (float)(log1p(-exp2((double)(-5 - h))) * 1.4426950408889634);
        const size_t brow0 = (size_t)b * 16384;
        bf16_t* vptr = VO + (brow0 + vs) * 4096 + vcol + 8 * vc8;
        u32x4 vraw = *(const u32x4*)vptr;
        const bf16_t* xq_b = XQ + (brow0 + r) * ldx + qcol + 32 * (wave * NP) + 8 * hh;
        const bf16_t* xk_b = XK + (brow0 + r) * ldx + qcol + 32 * (wave * NP) + 8 * hh;
        const bf16_t* xring_b = XQ + brow0 * ldx + qcol + 32 * (wave * NP);
        const bf16_t* xkring_b = XK + brow0 * ldx + qcol + 32 * (wave * NP);
        const unsigned rgo0 = (unsigned)((lane >> 2) * ldx + (((lane & 3) ^ ((lane >> 4) & 3)) * 8));
        const int rro0 = (4 * r + ((0 + hh) ^ ((r >> 2) & 3))) * 16;
        const unsigned rgoU = (unsigned)((lane >> 3) * ldx + (((lane & 7) ^ ((lane >> 3) & 7)) * 8));
        bf16x8 iw0, iw1; u32x2 qv[NP], kv[NP];
        if (ML) {
#pragma unroll
            for (int p = 0; p < NP; ++p) { const size_t to = (size_t)(h * NT + wave * NP + p) * 1024 + r * 32 + 4 * (r >> 2);
                qv[p] = *(const u32x2*)(WQ + to); kv[p] = *(const u32x2*)(WK + to); }
            iw0 = iw1 = (bf16x8){0, 0, 0, 0, 0, 0, 0, 0};
        } else { iw0 = ldg16(WQ + r * 32 + 8 * hh); iw1 = ldg16(WQ + r * 32 + 8 * hh + 16);
#pragma unroll
            for (int p = 0; p < NP; ++p) { qv[p] = (u32x2){0u, 0u}; kv[p] = (u32x2){0u, 0u}; } }
#define BDFRAG(v, ks) __builtin_bit_cast(bf16x8, (u32x4){bdsel == 2 * (ks) ? (v).x : 0u, bdsel == 2 * (ks) ? (v).y : 0u, bdsel == 2 * (ks) + 1 ? (v).x : 0u, bdsel == 2 * (ks) + 1 ? (v).y : 0u})
#define XOFF(n_, tt_, p_) (((size_t)(n_) * 128 + 32 * (tt_)) * ldx + 32 * (p_))
#define RING_ISSUE(slot_, off_) do { const bf16_t* g_ = xring_b + (off_); \
        __builtin_amdgcn_global_load_lds((const unsigned*)(g_ + rgo0), (LAS unsigned*)(l_ring + (slot_) * SS), 16, 0, 0); \
        __builtin_amdgcn_global_load_lds((const unsigned*)((g_ + 16 * ldx) + rgo0), (LAS unsigned*)(l_ring + (slot_) * SS + 1024), 16, 0, 0); \
        if (!ML) { const bf16_t* k_ = xkring_b + (off_); \
        __builtin_amdgcn_global_load_lds((const unsigned*)(k_ + rgo0), (LAS unsigned*)(l_ring + (slot_) * SS + 2048), 16, 0, 0); \
        __builtin_amdgcn_global_load_lds((const unsigned*)((k_ + 16 * ldx) + rgo0), (LAS unsigned*)(l_ring + (slot_) * SS + 3072), 16, 0, 0); } } while (0)
#define TILE_ISSUE(par_, rr_, t_) do { \
        if ((wave >> 1) == (t_)) __builtin_amdgcn_global_load_lds((const unsigned*)(P + (((rr_) + r) * H + h) * 128 + 32 * (t_) + 16 * (wave & 1) + 8 * hh), (LAS unsigned*)(l_pbr + (par_) * 1280), 16, 0, 0);     \
        __builtin_amdgcn_global_load_lds((const unsigned*)(INTER2 + ((rr_) + r) * 4 + h), (LAS unsigned*)(l_pbr + (par_) * 1280 + 1024), 4, 0, 0); } while (0)
#define UNIT_ISSUE(us_, off_) do { const bf16_t* g_ = xring_b + (off_); _Pragma("unroll") for (int i_ = 0; i_ < 4; ++i_) \
        __builtin_amdgcn_global_load_lds((const unsigned*)((g_ + (size_t)i_ * 8 * ldx) + rgoU), (LAS unsigned*)(l_ring + (us_) * 4096 + i_ * 1024), 16, 0, 0); } while (0)
#define SCAN_STEP(p, tt, Q0, Q1, K0, K1) do { \
        const bf16x8 wq0_ = ML ? BDFRAG(qv[p], 0) : iw0, wq1_ = ML ? BDFRAG(qv[p], 1) : iw1, wk0_ = ML ? BDFRAG(kv[p], 0) : iw0, wk1_ = ML ? BDFRAG(kv[p], 1) : iw1; \
        f32x16 qT = MFMA32(wq0_, Q0, z); qT = MFMA32(wq1_, Q1, qT); \
        { const bf16x8 sa0 = pack16(S[p], 0), sa1 = pack16(S[p], 1);     \
          Oacc = MFMA32(sa0, pack16(qT, 0), Oacc); Oacc = MFMA32(sa1, pack16(qT, 1), Oacc); } \
        if (ML) __builtin_amdgcn_sched_barrier(0);     \
        f32x16 kT = MFMA32(K0, wk0_, z); kT = MFMA32(K1, wk1_, kT); \
        const LAS bf16_t* vwp = l_vw + r * VP + 32 * (tt) + 4 * hh; \
        const s16x4 w00 = *(const LAS s16x4*)(vwp), w01 = *(const LAS s16x4*)(vwp + 8), w10 = *(const LAS s16x4*)(vwp + 16), w11 = *(const LAS s16x4*)(vwp + 24); \
        const bf16x8 vw0 = __builtin_shufflevector(w00, w01, 0, 1, 2, 3, 4, 5, 6, 7), vw1 = __builtin_shufflevector(w10, w11, 0, 1, 2, 3, 4, 5, 6, 7); \
        S[p] = MFMA32(pack16(kT, 0), vw0, S[p]); S[p] = MFMA32(pack16(kT, 1), vw1, S[p]); } while (0)
#define SCAN_TAIL(tt, PB, RSC2) do { \
        if ((wave >> 1) == (tt)) { const bf16x8 va = *(const LAS bf16x8*)(l_vw + r * VP + 32 * (tt) + 16 * (wave & 1) + 8 * hh); Oacc = MFMA32(va, (PB), Oacc); }     \
        _Pragma("unroll") for (int i = 0; i < 16; ++i) Oacc[i] *= (RSC2); \
        _Pragma("unroll") for (int i = 0; i < 16; ++i) lds_add_i(&l_os[(32 * (tt) + r) * 33 + crow(i, hh)], (int)rintf(Oacc[i] * OFIX)); } while (0)
        bf16x8 pb_n; float rsc2_n;
        if constexpr (ML) { TILE_ISSUE(0, brow0, 0); UNIT_ISSUE(0, XOFF(0, 0, 0)); UNIT_ISSUE(1, XOFF(0, 0, 2)); }
        else {
#pragma unroll
            for (int L = 0; L < NST; ++L) RING_ISSUE(L, XOFF(0, L / NP, L % NP));
        }
        pb_n = ldg16(P + ((brow0 + r) * H + h) * 128 + 16 * (wave & 1) + 8 * hh);
        rsc2_n = ML ? INTER2[(brow0 + r) * 4 + h] : exp2f((float)(r - 127) * l2g);
        float decay_n, colw_n;
        if (ML) { decay_n = DEC[(b * 128) * 4 + h]; colw_n = CW[(brow0 + vs) * 4 + h]; }
        else { decay_n = exp2f(128.f * l2g); colw_n = exp2f((float)(127 - vs) * l2g); }
        int slot = 0, uslot = 0; (void)slot; (void)uslot;
        __syncthreads();
        for (int n = 0; n < 128; ++n) {
            const size_t row0 = brow0 + (size_t)n * 128; const int n1 = n + 1 < 128 ? n + 1 : n;
            const float decay = decay_n, colw = colw_n;
            if (ML) { decay_n = DEC[(b * 128 + n1) * 4 + h]; colw_n = CW[(brow0 + (size_t)n1 * 128 + vs) * 4 + h]; }
            {
                float vin[8], vv[8]; unpack8(vraw, vin);
                if (ML) {
#pragma unroll
                    for (int bl = 0; bl < 2; ++bl)
#pragma unroll
                        for (int o = 0; o < 4; ++o) { const f32x4 w4 = *(const LAS f32x4*)(l_wv + (2 * vc8 + bl) * 16 + 4 * o); vv[4 * bl + o] = w4[0] * vin[4 * bl] + w4[1] * vin[4 * bl + 1] + w4[2] * vin[4 * bl + 2] + w4[3] * vin[4 * bl + 3]; }
                } else {
#pragma unroll
                    for (int e = 0; e < 8; ++e) vv[e] = vin[e];
                }
#pragma unroll
                for (int e = 0; e < 8; e += 2) {
                    const unsigned w = pk2(vv[e] * colw, vv[e + 1] * colw);
                    l_vw[(8 * vc8 + e) * VP + vs] = (bf16_t)(w & 0xffffu); l_vw[(8 * vc8 + e + 1) * VP + vs] = (bf16_t)(w >> 16);
                }
                vraw = *(const u32x4*)(vptr + (size_t)n1 * 128 * 4096);
            }
            __syncthreads();
            f32x16 z;
#pragma unroll
            for (int i = 0; i < 16; ++i) z[i] = 0.f;
#pragma unroll
            for (int p = 0; p < NP; ++p) {
#pragma unroll
                for (int i = 0; i < 16; ++i) S[p][i] *= decay;
            }
            if constexpr (ML) {
#pragma unroll 1
                for (int tt = 0; tt < 4; ++tt) {
                    f32x16 Oacc = z;
#pragma unroll
                    for (int pr = 0; pr < 2; ++pr) {
                        asm volatile("s_waitcnt vmcnt(4)" ::: "memory");
                        const LAS unsigned char* ub = l_ring + uslot * 4096 + r * 128;
                        {
                            const bf16x8 q0 = *(const LAS bf16x8*)(ub + (((0 + hh) ^ (r & 7)) * 16)), q1 = *(const LAS bf16x8*)(ub + (((2 + hh) ^ (r & 7)) * 16));
                            SCAN_STEP(2 * pr, tt, q0, q1, q0, q1);
                            __builtin_amdgcn_sched_barrier(0);
                        }
                        {
                            const bf16x8 q0 = *(const LAS bf16x8*)(ub + (((4 + hh) ^ (r & 7)) * 16)), q1 = *(const LAS bf16x8*)(ub + (((6 + hh) ^ (r & 7)) * 16));
                            asm volatile("s_waitcnt lgkmcnt(0)" ::: "memory");
                            { const int tq = tt + (pr + NU) / 2, t2 = tq & 3, n2 = tq >= 4 ? n1 : n; UNIT_ISSUE(uslot, XOFF(n2, t2, 2 * ((pr + NU) & 1))); }
                            if (pr == 0) { const int t1 = (tt + 1) & 3; TILE_ISSUE(t1 & 1, (tt == 3 ? brow0 + (size_t)n1 * 128 : row0) + 32 * t1, t1); }
                            uslot = uslot + 1 == NU ? 0 : uslot + 1;
                            SCAN_STEP(2 * pr + 1, tt, q0, q1, q0, q1);
                            __builtin_amdgcn_sched_barrier(0);
                        }
                    }
                    {
                        const bf16x8 pb = *(const LAS bf16x8*)(l_pbr + (tt & 1) * 1280 + lane * 16); const float rsc2 = *(const LAS float*)(l_pbr + (tt & 1) * 1280 + 1024 + lane * 4);
                        SCAN_TAIL(tt, pb, rsc2);
                    }
                }
            } else
            {
#pragma unroll 1
                for (int tt = 0; tt < 4; ++tt) {
                    f32x16 Oacc = z;
                    const bf16x8 pb = pb_n; const float rsc2 = rsc2_n;
                    { const int t1 = (tt + 1) & 3; const size_t rr = (tt == 3 ? brow0 + (size_t)n1 * 128 : row0) + 32 * t1 + r;
                      if ((wave >> 1) == t1) pb_n = ldg16(P + (rr * H + h) * 128 + 32 * t1 + 16 * (wave & 1) + 8 * hh);
                      rsc2_n = ML ? INTER2[rr * 4 + h] : exp2f((float)(32 * t1 + r - 127) * l2g); }
#pragma unroll
                    for (int p = 0; p < NP; ++p) {
                        if (ML) asm volatile("s_waitcnt vmcnt(4)" ::: "memory"); else asm volatile("s_waitcnt vmcnt(8)" ::: "memory");
                        const bf16x8 cq0 = *(const LAS bf16x8*)(l_ring + slot * SS + rro0), cq1 = *(const LAS bf16x8*)(l_ring + slot * SS + (rro0 ^ 32));
                        bf16x8 ck0, ck1; if (ML) { ck0 = cq0; ck1 = cq1; } else { ck0 = *(const LAS bf16x8*)(l_ring + slot * SS + 2048 + rro0); ck1 = *(const LAS bf16x8*)(l_ring + slot * SS + 2048 + (rro0 ^ 32)); }
                        asm volatile("s_waitcnt lgkmcnt(0)" ::: "memory");
                        { const int p3 = (p + NST) % NP, tq = tt + (p + NST) / NP; const int t3 = tq & 3, n3 = tq >= 4 ? n1 : n; RING_ISSUE(slot, XOFF(n3, t3, p3)); }
                        slot = slot + 1 == NST ? 0 : slot + 1;
#if defined(PROBE_SKIP) && (PROBE_SKIP & 1)
                        if (do_store) { SCAN_STEP(p, tt, cq0, cq1, ck0, ck1); } else { S[p][0] += (float)cq0[0] + (float)ck1[0]; }
#else
                        SCAN_STEP(p, tt, cq0, cq1, ck0, ck1);
#endif
                        __builtin_amdgcn_sched_barrier(0);
                    }
                    SCAN_TAIL(tt, pb, rsc2);
                }
            }
            __syncthreads();
            {
                float o[8]; LAS int* op = l_os + vs * 33 + 8 * vc8;
#pragma unroll
                for (int e = 0; e < 8; ++e) { o[e] = (float)op[e] * OFIX_INV; op[e] = 0; }
                if (do_store) *(u32x4*)(vptr + (size_t)n * 128 * 4096) = pack8f(o);
            }
        }
        asm volatile("s_waitcnt vmcnt(0)" ::: "memory");
        __syncthreads();
#undef BDFRAG
#undef XOFF
#undef RING_ISSUE
#undef UNIT_ISSUE
#undef TILE_ISSUE
#undef SCAN_STEP
#undef SCAN_TAIL
    }
}


#define XB_TMO      128
#define XB_XCNT(j)  (256  + 64 * (j))
#define XB_XSUB(j)  (1280 + 64 * (j))
#define XB_XGEN(j)  (2304 + 64 * (j))
#define XB_TOP      3328
#define XB_TOPGEN   3392
#define XCD_BAR_WORDS 3456
#define XB_SPIN_CAP (1u << 18)
__device__ __forceinline__ unsigned xb_ld(unsigned* p)              { return __hip_atomic_load(p, __ATOMIC_RELAXED, __HIP_MEMORY_SCOPE_AGENT); }
__device__ __forceinline__ unsigned xb_add(unsigned* p, unsigned v) { return __hip_atomic_fetch_add(p, v, __ATOMIC_RELAXED, __HIP_MEMORY_SCOPE_AGENT); }
__device__ __forceinline__ unsigned xb_xcc_id() { return (unsigned)__builtin_amdgcn_s_getreg((3 << 11) | 20) & 0xFu; }
#define XB_SPIN(cond, bar) do { unsigned _sp = 0; while (cond) { __builtin_amdgcn_s_sleep(1); \
    if ((++_sp & 255u) == 0u) { if (xb_ld(&(bar)[XB_TMO])) break; if (_sp > XB_SPIN_CAP) { atomicAdd(&(bar)[XB_TMO], 1u); break; } } } } while (0)
struct XcdBarrier { unsigned* bar; unsigned x; volatile LAS unsigned* st; };
__device__ __forceinline__ XcdBarrier xcd_barrier_post(unsigned* bar, volatile LAS unsigned* st) {
    XcdBarrier b; b.bar = bar; b.x = xb_xcc_id(); b.st = st;
    if (threadIdx.x == 0) (void)xb_add(&bar[XB_XCNT(b.x)], 1u);
    return b;
}
__device__ __forceinline__ void xcd_barrier_complete(unsigned* bar, unsigned x, unsigned& nloc, unsigned& nx) {
    const unsigned G = gridDim.x * gridDim.y * gridDim.z;
    unsigned sum, cnt, mine, sp = 0u;
    for (;;) {
        sum = 0u; cnt = 0u; mine = 0u;
#pragma unroll
        for (unsigned j = 0; j < 16; ++j) { const unsigned c = xb_ld(&bar[XB_XCNT(j)]); sum += c; cnt += (c > 0u) ? 1u : 0u; mine = (j == x) ? c : mine; }
        if (sum == G) break;
        __builtin_amdgcn_s_sleep(1);
        if ((++sp & 255u) == 0u) { if (xb_ld(&bar[XB_TMO])) break; if (sp > XB_SPIN_CAP) { atomicAdd(&bar[XB_TMO], 1u); break; } }
    }
    nloc = mine > 0u ? mine : 1u; nx = cnt > 0u ? cnt : 1u;
}
__device__ __forceinline__ void xcd_barrier(const XcdBarrier& b) {
    asm volatile("s_waitcnt vmcnt(0)" ::: "memory");
    __syncthreads();
    if (threadIdx.x == 0) {
        unsigned* bar = b.bar;
        __builtin_amdgcn_s_waitcnt(0);
        unsigned nloc = b.st[0], nx = b.st[1];
        if (nloc == 0u) { xcd_barrier_complete(bar, b.x, nloc, nx); b.st[0] = nloc; b.st[1] = nx; }
        const unsigned old = xb_add(&bar[XB_XSUB(b.x)], 1u);
        const unsigned gen = old / nloc;
        if (old + 1u == (gen + 1u) * nloc) {
            __builtin_amdgcn_fence(__ATOMIC_RELEASE, "agent");
            asm volatile("s_waitcnt vmcnt(0)" ::: "memory");
            const unsigned og = xb_add(&bar[XB_TOP], 1u);
            const unsigned tg = og / nx;
            if (og + 1u == (tg + 1u) * nx) xb_add(&bar[XB_TOPGEN], 1u);
            else XB_SPIN(xb_ld(&bar[XB_TOPGEN]) == tg, bar);
            __builtin_amdgcn_fence(__ATOMIC_ACQUIRE, "agent");
            xb_add(&bar[XB_XGEN(b.x)], 1u);
            asm volatile("s_waitcnt vmcnt(0)" ::: "memory");
        } else {
            XB_SPIN(xb_ld(&bar[XB_XGEN(b.x)]) == gen, bar);
            __builtin_amdgcn_fence(__ATOMIC_ACQUIRE, "agent");
            asm volatile("s_waitcnt vmcnt(0)" ::: "memory");
        }
    }
    __syncthreads();
}

constexpr int LDS_BYTES = 163840;
enum { PH_PRO = 0, PH_G1, PH_RP, PH_RS, PH_RF, PH_G2, PH_G3, PH_G4, PH_G5, PH_MC, PH_MP, PH_MS, PH_MF, PH_G6, PH_G7, PH_G8, PH_FIN, PH_N };

__global__ void __launch_bounds__(512) mega(Params p) {
    extern __shared__ __attribute__((aligned(16))) unsigned char shm[];
    LAS unsigned char* lds = (LAS unsigned char*)shm;
    cg::grid_group grid = cg::this_grid();
    const int tid = threadIdx.x, wave = __builtin_amdgcn_readfirstlane(tid >> 6), lane = tid & 63;
    const int G = gridDim.x, gw = blockIdx.x * 8 + wave, ngw = G * 8;
    const size_t gtid = (size_t)blockIdx.x * 512 + tid, gthreads = (size_t)G * 512;
    unsigned char* ws = p.ws;
    u64* sumsq = (u64*)(ws + WS_SUMSQ);
    bf16_t* hb = (bf16_t*)(ws + WS_RA);
    float* out = p.out;
    unsigned char* dob = (unsigned char*)p.out;
    LAS float* scr = (LAS float*)(lds + wave * 16384);
    const int lo = p.ph_lo, hi = p.ph_hi;
#ifdef ONLY_PHASE
#define IN(k) ((k) == ONLY_PHASE && lo <= (k) && (k) < hi)
#else
#define IN(k) (lo <= (k) && (k) < hi)
#endif
#ifndef MK_XCD_BARRIER
#define MK_XCD_BARRIER 1
#endif
    volatile LAS unsigned* bst = (volatile LAS unsigned*)(lds + LDS_BYTES - 64);
    if (tid < 2) bst[tid] = 0u;
    __syncthreads();
    XcdBarrier xbar; xbar.bar = (unsigned*)(ws + WS_BAR); xbar.x = 0; xbar.st = bst;
    if (MK_XCD_BARRIER && hi - lo > 1) xbar = xcd_barrier_post((unsigned*)(ws + WS_BAR), bst);
#define SEAM(k) do { if (IN(k) && IN((k) + 1)) { if (!MK_XCD_BARRIER || (k) == PH_PRO) grid.sync(); else xcd_barrier(xbar); } } while (0)
#ifndef REP_MASK
#define REP_MASK 0
#endif
    int mf_pass_ = 0; (void)mf_pass_;


    if (IN(PH_PRO)) {
        for (size_t i = gtid; i < (size_t)4 * T; i += gthreads) sumsq[T + i] = 0ull;
        {
            f32x4 nx[8];
            if (gw < T) { const f32x4* xr = (const f32x4*)(p.in[0] + (size_t)gw * DM) + lane;
#pragma unroll
                for (int j = 0; j < 8; ++j) nx[j] = xr[64 * j]; }
            for (int m = gw; m < T; m += ngw) {
                f32x4 cx[8];
#pragma unroll
                for (int j = 0; j < 8; ++j) cx[j] = nx[j];
                { const int mn = m + ngw < T ? m + ngw : m; const f32x4* xr = (const f32x4*)(p.in[0] + (size_t)mn * DM) + lane;
#pragma unroll
                  for (int j = 0; j < 8; ++j) nx[j] = xr[64 * j]; }
                float s = 0.f;
                unsigned long long* o8 = (unsigned long long*)(hb + (size_t)m * DM) + lane;
#pragma unroll
                for (int j = 0; j < 8; ++j) { const f32x4 v = cx[j]; s += (v[0] * v[0] + v[1] * v[1]) + (v[2] * v[2] + v[3] * v[3]);
                    o8[64 * j] = (unsigned long long)pk2(v[0], v[1]) | ((unsigned long long)pk2(v[2], v[3]) << 32); }
                s = wave_sum(s); if (lane == 0) sumsq[m] = ss_fix(s);
            }
        }
        convert_weight(p.in[4], DM, 12288, (bf16_t*)(dob + DO_WT1), p.in[2], 0, scr, gw, ngw, lane);
        convert_weight(p.in[6], 4096, DM, (bf16_t*)(ws + WS_WT2), nullptr, 0, scr, gw, ngw, lane);
        convert_weight(p.in[18], DM, FF, (bf16_t*)(ws + WS_WT3), p.in[3], 1, scr, gw, ngw, lane);
        convert_weight(p.in[19], DM, FF, (bf16_t*)(ws + WS_WT3), p.in[3], 2, scr, gw, ngw, lane);
        convert_weight(p.in[20], FF, DM, (bf16_t*)(ws + WS_WT4), nullptr, 0, scr, gw, ngw, lane);
        { const int* pos = (const int*)p.in[1]; f32x2* cs = (f32x2*)(dob + DO_CS);
            for (size_t i = gtid; i < (size_t)T * 128; i += gthreads) { const int t = (int)(i >> 7), f = (int)(i & 127);
                const float inv = exp2f(-(float)f * (13.287712379549449f / 128.0f)); const float ang = (float)pos[t] * inv;
                cs[i] = (f32x2){cosf(ang), sinf(ang)}; } }
        { bf16_t* bdq = (bf16_t*)(ws + WS_BDQ); bf16_t* bdk = (bf16_t*)(ws + WS_BDK); bf16_t* idt = (bf16_t*)(ws + WS_IDT);
            for (size_t i = gtid; i < (size_t)128 * 1024; i += gthreads) { const int tile = (int)(i >> 10), d = (int)((i >> 5) & 31), c = (int)(i & 31);
                float q = 0.f, k = 0.f; if ((d >> 2) == (c >> 2)) { const size_t wi = (size_t)(tile * 8 + (d >> 2)) * 16 + (d & 3) * 4 + (c & 3); q = p.in[10][wi]; k = p.in[11][wi] * 0.03125f; }
                bdq[i] = (bf16_t)(pk2(q, 0.f) & 0xffffu); bdk[i] = (bf16_t)(pk2(k, 0.f) & 0xffffu);
                if (i < 1024) idt[i] = (d == c) ? (bf16_t)0x3f80u : (bf16_t)0; }
            u32x2* bqc = (u32x2*)(ws + WS_BDQC); u32x2* bkc = (u32x2*)(ws + WS_BDKC);
            for (size_t i = gtid; i < (size_t)128 * 32; i += gthreads) { const int tile = (int)(i >> 5), rr = (int)(i & 31); const size_t wi = (size_t)(tile * 8 + (rr >> 2)) * 16 + (rr & 3) * 4;
                bqc[i] = (u32x2){pk2(p.in[10][wi], p.in[10][wi + 1]), pk2(p.in[10][wi + 2], p.in[10][wi + 3])};
                bkc[i] = (u32x2){pk2(p.in[11][wi] * 0.03125f, p.in[11][wi + 1] * 0.03125f), pk2(p.in[11][wi + 2] * 0.03125f, p.in[11][wi + 3] * 0.03125f)}; } }
        { bf16_t* wch = (bf16_t*)(ws + WS_WGC); bf16_t* wcl = wch + 32768; bf16_t* wmh = (bf16_t*)(ws + WS_WGM); bf16_t* wml = wmh + 32768; const float* wg = p.in[13];
            for (size_t i = gtid; i < (size_t)4096 * 8; i += gthreads) { const int c = (int)(i >> 3), g = (int)(i & 7), nb = c >> 2, ii = c & 3; float a = 0.f, bm = 0.f;
#pragma unroll
                for (int o = 0; o < 4; ++o) { const size_t wi = (size_t)nb * 16 + o * 4 + ii;
                    a += p.in[10][wi] * wg[(size_t)(4 * nb + o) * 8 + g] + p.in[11][wi] * wg[(size_t)(4096 + 4 * nb + o) * 8 + g];
                    bm += p.in[12][wi] * wg[(size_t)(8192 + 4 * nb + o) * 8 + g]; }
                const unsigned ah = pk2(a, 0.f) & 0xffffu, mh = pk2(bm, 0.f) & 0xffffu;
                wch[g * 4096 + c] = (bf16_t)ah; wcl[g * 4096 + c] = (bf16_t)(pk2(a - bflo(ah), 0.f) & 0xffffu);
                wmh[g * 4096 + c] = (bf16_t)mh; wml[g * 4096 + c] = (bf16_t)(pk2(bm - bflo(mh), 0.f) & 0xffffu); } }
    }
#if (REP_MASK >> 0) & 1
    grid.sync();
    if (IN(PH_PRO)) {
        for (size_t i = gtid; i < (size_t)4 * T; i += gthreads) sumsq[T + i] = 0ull;
        {
            f32x4 nx[8];
            if (gw < T) { const f32x4* xr = (const f32x4*)(p.in[0] + (size_t)gw * DM) + lane;
#pragma unroll
                for (int j = 0; j < 8; ++j) nx[j] = xr[64 * j]; }
            for (int m = gw; m < T; m += ngw) {
                f32x4 cx[8];
#pragma unroll
                for (int j = 0; j < 8; ++j) cx[j] = nx[j];
                { const int mn = m + ngw < T ? m + ngw : m; const f32x4* xr = (const f32x4*)(p.in[0] + (size_t)mn * DM) + lane;
#pragma unroll
                  for (int j = 0; j < 8; ++j) nx[j] = xr[64 * j]; }
                float s = 0.f;
                unsigned long long* o8 = (unsigned long long*)(hb + (size_t)m * DM) + lane;
#pragma unroll
                for (int j = 0; j < 8; ++j) { const f32x4 v = cx[j]; s += (v[0] * v[0] + v[1] * v[1]) + (v[2] * v[2] + v[3] * v[3]);
                    o8[64 * j] = (unsigned long long)pk2(v[0], v[1]) | ((unsigned long long)pk2(v[2], v[3]) << 32); }
                s = wave_sum(s); if (lane == 0) sumsq[m] = ss_fix(s);
            }
        }
        convert_weight(p.in[4], DM, 12288, (bf16_t*)(dob + DO_WT1), p.in[2], 0, scr, gw, ngw, lane);
        convert_weight(p.in[6], 4096, DM, (bf16_t*)(ws + WS_WT2), nullptr, 0, scr, gw, ngw, lane);
        convert_weight(p.in[18], DM, FF, (bf16_t*)(ws + WS_WT3), p.in[3], 1, scr, gw, ngw, lane);
        convert_weight(p.in[19], DM, FF, (bf16_t*)(ws + WS_WT3), p.in[3], 2, scr, gw, ngw, lane);
        convert_weight(p.in[20], FF, DM, (bf16_t*)(ws + WS_WT4), nullptr, 0, scr, gw, ngw, lane);
        { const int* pos = (const int*)p.in[1]; f32x2* cs = (f32x2*)(dob + DO_CS);
            for (size_t i = gtid; i < (size_t)T * 128; i += gthreads) { const int t = (int)(i >> 7), f = (int)(i & 127);
                const float inv = exp2f(-(float)f * (13.287712379549449f / 128.0f)); const float ang = (float)pos[t] * inv;
                cs[i] = (f32x2){cosf(ang), sinf(ang)}; } }
        { bf16_t* bdq = (bf16_t*)(ws + WS_BDQ); bf16_t* bdk = (bf16_t*)(ws + WS_BDK); bf16_t* idt = (bf16_t*)(ws + WS_IDT);
            for (size_t i = gtid; i < (size_t)128 * 1024; i += gthreads) { const int tile = (int)(i >> 10), d = (int)((i >> 5) & 31), c = (int)(i & 31);
                float q = 0.f, k = 0.f; if ((d >> 2) == (c >> 2)) { const size_t wi = (size_t)(tile * 8 + (d >> 2)) * 16 + (d & 3) * 4 + (c & 3); q = p.in[10][wi]; k = p.in[11][wi] * 0.03125f; }
                bdq[i] = (bf16_t)(pk2(q, 0.f) & 0xffffu); bdk[i] = (bf16_t)(pk2(k, 0.f) & 0xffffu);
                if (i < 1024) idt[i] = (d == c) ? (bf16_t)0x3f80u : (bf16_t)0; }
            u32x2* bqc = (u32x2*)(ws + WS_BDQC); u32x2* bkc = (u32x2*)(ws + WS_BDKC);
            for (size_t i = gtid; i < (size_t)128 * 32; i += gthreads) { const int tile = (int)(i >> 5), rr = (int)(i & 31); const size_t wi = (size_t)(tile * 8 + (rr >> 2)) * 16 + (rr & 3) * 4;
                bqc[i] = (u32x2){pk2(p.in[10][wi], p.in[10][wi + 1]), pk2(p.in[10][wi + 2], p.in[10][wi + 3])};
                bkc[i] = (u32x2){pk2(p.in[11][wi] * 0.03125f, p.in[11][wi + 1] * 0.03125f), pk2(p.in[11][wi + 2] * 0.03125f, p.in[11][wi + 3] * 0.03125f)}; } }
        { bf16_t* wch = (bf16_t*)(ws + WS_WGC); bf16_t* wcl = wch + 32768; bf16_t* wmh = (bf16_t*)(ws + WS_WGM); bf16_t* wml = wmh + 32768; const float* wg = p.in[13];
            for (size_t i = gtid; i < (size_t)4096 * 8; i += gthreads) { const int c = (int)(i >> 3), g = (int)(i & 7), nb = c >> 2, ii = c & 3; float a = 0.f, bm = 0.f;
#pragma unroll
                for (int o = 0; o < 4; ++o) { const size_t wi = (size_t)nb * 16 + o * 4 + ii;
                    a += p.in[10][wi] * wg[(size_t)(4 * nb + o) * 8 + g] + p.in[11][wi] * wg[(size_t)(4096 + 4 * nb + o) * 8 + g];
                    bm += p.in[12][wi] * wg[(size_t)(8192 + 4 * nb + o) * 8 + g]; }
                const unsigned ah = pk2(a, 0.f) & 0xffffu, mh = pk2(bm, 0.f) & 0xffffu;
                wch[g * 4096 + c] = (bf16_t)ah; wcl[g * 4096 + c] = (bf16_t)(pk2(a - bflo(ah), 0.f) & 0xffffu);
                wmh[g * 4096 + c] = (bf16_t)mh; wml[g * 4096 + c] = (bf16_t)(pk2(bm - bflo(mh), 0.f) & 0xffffu); } }
    }
#endif
    SEAM(PH_PRO);

    if (IN(PH_G1)) {
        pg8::Gemm g{hb, (const bf16_t*)(dob + DO_WT1), T, 12288, DM}; pg8::StaticOrder S; S.init(T, 12288, G, (int)blockIdx.x);
        EpiRetIn E{(bf16_t*)(ws + WS_Q), (bf16_t*)(ws + WS_K), (bf16_t*)(ws + WS_V), (bf16_t*)(ws + WS_G), sumsq, (const float*)(dob + DO_CS)};
        pg8::gemm_phase(lds, g, S, E);
    }
#if (REP_MASK >> 1) & 1
    grid.sync();
    if (IN(PH_G1)) {
        pg8::Gemm g{hb, (const bf16_t*)(dob + DO_WT1), T, 12288, DM}; pg8::StaticOrder S; S.init(T, 12288, G, (int)blockIdx.x);
        EpiRetIn E{(bf16_t*)(ws + WS_Q), (bf16_t*)(ws + WS_K), (bf16_t*)(ws + WS_V), (bf16_t*)(ws + WS_G), sumsq, (const float*)(dob + DO_CS)};
        pg8::gemm_phase(lds, g, S, E);
    }
#endif
    SEAM(PH_G1);
    if (IN(PH_RP)) {
        const bf16_t* idt = (const bf16_t*)(ws + WS_IDT);
        phase_scores<8, false>((const bf16_t*)(ws + WS_Q), (const bf16_t*)(ws + WS_K), 2048, idt, nullptr, nullptr, 8, (bf16_t*)(dob + DO_P0), nullptr, nullptr, nullptr, nullptr, nullptr, nullptr, nullptr, nullptr, nullptr, nullptr, nullptr, nullptr, lds);
    }
#if (REP_MASK >> 2) & 1
    grid.sync();
    if (IN(PH_RP)) {
        const bf16_t* idt = (const bf16_t*)(ws + WS_IDT);
        phase_scores<8, false>((const bf16_t*)(ws + WS_Q), (const bf16_t*)(ws + WS_K), 2048, idt, nullptr, nullptr, 8, (bf16_t*)(dob + DO_P0), nullptr, nullptr, nullptr, nullptr, nullptr, nullptr, nullptr, nullptr, nullptr, nullptr, nullptr, nullptr, lds);
    }
#endif
    SEAM(PH_RP);
    if (IN(PH_RS)) {
        const bf16_t* idt = (const bf16_t*)(ws + WS_IDT);
        phase_scan<1, false>((const bf16_t*)(ws + WS_Q), (const bf16_t*)(ws + WS_K), 2048, idt, idt, 8, 512, (bf16_t*)(ws + WS_V), (const bf16_t*)(dob + DO_P0), nullptr, nullptr, nullptr, nullptr, nullptr, lds, !((REP_MASK >> 3) & 1));
    }
#if (REP_MASK >> 3) & 1
    grid.sync();
    if (IN(PH_RS)) {
        const bf16_t* idt = (const bf16_t*)(ws + WS_IDT);
        phase_scan<1, false>((const bf16_t*)(ws + WS_Q), (const bf16_t*)(ws + WS_K), 2048, idt, idt, 8, 512, (bf16_t*)(ws + WS_V), (const bf16_t*)(dob + DO_P0), nullptr, nullptr, nullptr, nullptr, nullptr, lds);
    }
#endif
    SEAM(PH_RS);
    if (IN(PH_RF)) {
        const bf16_t* O = (const bf16_t*)(ws + WS_V); const bf16_t* Gt = (const bf16_t*)(ws + WS_G); bf16_t* Y = (bf16_t*)(ws + WS_Y); const float* gn = p.in[5];
        for (int it0 = gw; it0 < T * 8; it0 += 4 * ngw) {
            u32x4 ro[4], rg[4];
#pragma unroll
            for (int u = 0; u < 4; ++u) { const int it = it0 + u * ngw < T * 8 ? it0 + u * ngw : it0; const size_t off = (size_t)(it >> 3) * 4096 + (it & 7) * 512 + lane * 8;
                ro[u] = *(const u32x4*)(O + off); rg[u] = *(const u32x4*)(Gt + off); }
#pragma unroll
            for (int u = 0; u < 4; ++u) {
                const int it = it0 + u * ngw; if (it >= T * 8) break;
                const size_t off = (size_t)(it >> 3) * 4096 + (it & 7) * 512 + lane * 8;
                float o[8], gt[8]; unpack8(ro[u], o); unpack8(rg[u], gt);
                float s = 0.f;
#pragma unroll
                for (int e = 0; e < 8; ++e) s += o[e];
                const float mu = wave_sum(s) * (1.f / 512.f); float q = 0.f;
#pragma unroll
                for (int e = 0; e < 8; ++e) { o[e] -= mu; q += o[e] * o[e]; }
                const float rstd = rsqrtf(wave_sum(q) * (1.f / 512.f) + EPSN);
                const f32x4 g0 = *(const f32x4*)(gn + (it & 7) * 512 + lane * 8), g1 = *(const f32x4*)(gn + (it & 7) * 512 + lane * 8 + 4);
                float y[8];
#pragma unroll
                for (int e = 0; e < 8; ++e) y[e] = o[e] * rstd * (e < 4 ? g0[e & 3] : g1[e & 3]) * silu_f(gt[e]);
                *(u32x4*)(Y + off) = pack8f(y);
            }
        }
    }
#if (REP_MASK >> 4) & 1
    grid.sync();
    if (IN(PH_RF)) {
        const bf16_t* O = (const bf16_t*)(ws + WS_V); const bf16_t* Gt = (const bf16_t*)(ws + WS_G); bf16_t* Y = (bf16_t*)(ws + WS_Y); const float* gn = p.in[5];
        for (int it0 = gw; it0 < T * 8; it0 += 4 * ngw) {
            u32x4 ro[4], rg[4];
#pragma unroll
            for (int u = 0; u < 4; ++u) { const int it = it0 + u * ngw < T * 8 ? it0 + u * ngw : it0; const size_t off = (size_t)(it >> 3) * 4096 + (it & 7) * 512 + lane * 8;
                ro[u] = *(const u32x4*)(O + off); rg[u] = *(const u32x4*)(Gt + off); }
#pragma unroll
            for (int u = 0; u < 4; ++u) {
                const int it = it0 + u * ngw; if (it >= T * 8) break;
                const size_t off = (size_t)(it >> 3) * 4096 + (it & 7) * 512 + lane * 8;
                float o[8], gt[8]; unpack8(ro[u], o); unpack8(rg[u], gt);
                float s = 0.f;
#pragma unroll
                for (int e = 0; e < 8; ++e) s += o[e];
                const float mu = wave_sum(s) * (1.f / 512.f); float q = 0.f;
#pragma unroll
                for (int e = 0; e < 8; ++e) { o[e] -= mu; q += o[e] * o[e]; }
                const float rstd = rsqrtf(wave_sum(q) * (1.f / 512.f) + EPSN);
                const f32x4 g0 = *(const f32x4*)(gn + (it & 7) * 512 + lane * 8), g1 = *(const f32x4*)(gn + (it & 7) * 512 + lane * 8 + 4);
                float y[8];
#pragma unroll
                for (int e = 0; e < 8; ++e) y[e] = o[e] * rstd * (e < 4 ? g0[e & 3] : g1[e & 3]) * silu_f(gt[e]);
                *(u32x4*)(Y + off) = pack8f(y);
            }
        }
    }
#endif
    SEAM(PH_RF);
    if (IN(PH_G2)) {
        convert_weight(p.in[7], DM, 8192, (bf16_t*)(ws + WS_WT5), p.in[2] + DM, 0, scr, gw, ngw, lane);
        __syncthreads();
        pg8::Gemm g{(const bf16_t*)(ws + WS_Y), (const bf16_t*)(ws + WS_WT2), T, DM, 4096}; pg8::StaticOrder S; S.init(T, DM, G, (int)blockIdx.x);
        EpiResid E{hb, sumsq + T};
        pg8::gemm_phase(lds, g, S, E);
    }
#if (REP_MASK >> 5) & 1
    grid.sync();
    if (IN(PH_G2)) {
        convert_weight(p.in[7], DM, 8192, (bf16_t*)(ws + WS_WT5), p.in[2] + DM, 0, scr, gw, ngw, lane);
        __syncthreads();
        pg8::Gemm g{(const bf16_t*)(ws + WS_Y), (const bf16_t*)(ws + WS_WT2), T, DM, 4096}; pg8::StaticOrder S; S.init(T, DM, G, (int)blockIdx.x);
        EpiResid E{hb, sumsq + T};
        pg8::gemm_phase(lds, g, S, E);
    }
#endif
    SEAM(PH_G2);
    if (IN(PH_G3)) {
        pg8::Gemm g{hb, (const bf16_t*)(ws + WS_WT3), T, 2 * FF, DM}; pg8::StaticOrder S; S.init(T, 2 * FF, G, (int)blockIdx.x);
        EpiSwiGLU E{(bf16_t*)(ws + WS_ACT0), sumsq + T};
        pg8::gemm_phase(lds, g, S, E);
    }
#if (REP_MASK >> 6) & 1
    grid.sync();
    if (IN(PH_G3)) {
        pg8::Gemm g{hb, (const bf16_t*)(ws + WS_WT3), T, 2 * FF, DM}; pg8::StaticOrder S; S.init(T, 2 * FF, G, (int)blockIdx.x);
        EpiSwiGLU E{(bf16_t*)(ws + WS_ACT0), sumsq + T};
        pg8::gemm_phase(lds, g, S, E);
    }
#endif
    SEAM(PH_G3);
    if (IN(PH_G4)) {
        pg8::Gemm g{(const bf16_t*)(ws + WS_ACT0), (const bf16_t*)(ws + WS_WT4), T, DM, FF}; pg8::StaticOrder S; S.init(T, DM, G, (int)blockIdx.x);
        EpiResid E{hb, sumsq + 2 * T};
        pg8::gemm_phase(lds, g, S, E);
    }
#if (REP_MASK >> 7) & 1
    grid.sync();
    if (IN(PH_G4)) {
        pg8::Gemm g{(const bf16_t*)(ws + WS_ACT0), (const bf16_t*)(ws + WS_WT4), T, DM, FF}; pg8::StaticOrder S; S.init(T, DM, G, (int)blockIdx.x);
        EpiResid E{hb, sumsq + 2 * T};
        pg8::gemm_phase(lds, g, S, E);
    }
#endif
    SEAM(PH_G4);

    if (IN(PH_G5)) {
        convert_weight(p.in[17], 4096, DM, (bf16_t*)(ws + WS_WT6), nullptr, 0, scr, gw, ngw, lane);
        convert_weight(p.in[18] + (size_t)DM * FF, DM, FF, (bf16_t*)(ws + WS_WT7), p.in[3] + DM, 1, scr, gw, ngw, lane);
        convert_weight(p.in[19] + (size_t)DM * FF, DM, FF, (bf16_t*)(ws + WS_WT7), p.in[3] + DM, 2, scr, gw, ngw, lane);
        convert_weight(p.in[20] + (size_t)FF * DM, FF, DM, (bf16_t*)(ws + WS_WT8), nullptr, 0, scr, gw, ngw, lane);
        __syncthreads();
        pg8::Gemm g{hb, (const bf16_t*)(ws + WS_WT5), T, 8192, DM}; pg8::StaticOrder S; S.init(T, 8192, G, (int)blockIdx.x);
        EpiMlIn E{(bf16_t*)(ws + WS_XM), (bf16_t*)(ws + WS_Z), sumsq + 2 * T};
        pg8::gemm_phase(lds, g, S, E);
    }
#if (REP_MASK >> 8) & 1
    grid.sync();
    if (IN(PH_G5)) {
        convert_weight(p.in[17], 4096, DM, (bf16_t*)(ws + WS_WT6), nullptr, 0, scr, gw, ngw, lane);
        convert_weight(p.in[18] + (size_t)DM * FF, DM, FF, (bf16_t*)(ws + WS_WT7), p.in[3] + DM, 1, scr, gw, ngw, lane);
        convert_weight(p.in[19] + (size_t)DM * FF, DM, FF, (bf16_t*)(ws + WS_WT7), p.in[3] + DM, 2, scr, gw, ngw, lane);
        convert_weight(p.in[20] + (size_t)FF * DM, FF, DM, (bf16_t*)(ws + WS_WT8), nullptr, 0, scr, gw, ngw, lane);
        __syncthreads();
        pg8::Gemm g{hb, (const bf16_t*)(ws + WS_WT5), T, 8192, DM}; pg8::StaticOrder S; S.init(T, 8192, G, (int)blockIdx.x);
        EpiMlIn E{(bf16_t*)(ws + WS_XM), (bf16_t*)(ws + WS_Z), sumsq + 2 * T};
        pg8::gemm_phase(lds, g, S, E);
    }
#endif
    SEAM(PH_G5);
    if (IN(PH_MC)) {
        const bf16_t* XM = (const bf16_t*)(ws + WS_XM); bf16_t* XC = (bf16_t*)(ws + WS_XC);
        const bf16_t* wch = (const bf16_t*)(ws + WS_WGC); const bf16_t* wcl = wch + 32768; const bf16_t* wmh = (const bf16_t*)(ws + WS_WGM); const bf16_t* wml = wmh + 32768;
        float* GA = (float*)(ws + WS_GA); float* GPM = (float*)(ws + WS_GPM); float* GB = (float*)(ws + WS_GB); float* BL = (float*)(ws + WS_BLAST); float* PL = (float*)(ws + WS_PML);
        LAS unsigned char* img0 = lds;
        LAS float* l_gp = (LAS float*)(lds + 81920);
        LAS float* l_ig = l_gp + 2048;
        LAS float* l_lf = l_ig + 512;
        const int r = lane & 31, hh = lane >> 5, rb = wave & 3, chh = wave >> 2;
        const int dslot = (tid & 15) ^ ((tid >> 4) & 15);
        LAS bf16_t* l_gw = (LAS bf16_t*)(lds + 94208); LAS float* l_cwb = (LAS float*)(lds + 94208 + 2 * 8704);
        const int wg_arr = tid >> 7, wg_row = (tid >> 4) & 7, wg_ch = tid & 15;
        const bf16_t* wg_src = (wg_arr == 0 ? wch : wg_arr == 1 ? wcl : wg_arr == 2 ? wmh : wml) + (size_t)wg_row * 4096 + wg_ch * 8;
        const float* cw_src = (tid < 128 ? p.in[8] + (size_t)(tid >> 5) * 4096 : p.in[9]) + (tid & 31) * 4;
        for (int cb = blockIdx.x; cb < NCB; cb += G) {
            const size_t row0 = (size_t)cb * 128; const bool first = (cb & 127) == 0;
            const int lr = 32 * rb + r; const size_t trow = row0 + lr;
            const bool ok0 = !first || lr >= 3, ok1 = !first || lr >= 2, ok2 = !first || lr >= 1;
            const bf16_t* dma_lo = XM + (first ? row0 + (size_t)(tid >> 4) : row0 - 32 + (size_t)(tid >> 4)) * 4096 + dslot * 8;
            const bf16_t* dma_hi = XM + (row0 + (size_t)(tid >> 4)) * 4096 + dslot * 8;
#define MC_ISSUE(bufi, stp) do { LAS unsigned char* d_ = img0 + (bufi) * 40960 + wave * 1024; \
            __builtin_amdgcn_global_load_lds((const unsigned*)(dma_lo + (stp) * 128), (LAS unsigned*)d_, 16, 0, 0); \
            _Pragma("unroll") for (int j_ = 0; j_ < 4; ++j_) __builtin_amdgcn_global_load_lds((const unsigned*)(dma_hi + (size_t)j_ * 32 * 4096 + (stp) * 128), (LAS unsigned*)(d_ + (j_ + 1) * 8192), 16, 0, 0); } while (0)
            f32x16 acc;
#pragma unroll
            for (int i = 0; i < 16; ++i) acc[i] = 0.f;
            const u32x4 zz4 = {0u, 0u, 0u, 0u};
            MC_ISSUE(0, 0);
            { *(LAS u32x4*)(l_gw + (wg_arr * 8 + wg_row) * 136 + wg_ch * 8) = *(const u32x4*)wg_src; if (tid < 160) *(LAS f32x4*)(l_cwb + (tid >> 5) * 128 + (tid & 31) * 4) = *(const f32x4*)cw_src; }
#pragma unroll 1
            for (int step = 0; step < 32; ++step) {
                const int sn = step + 1 < 32 ? step + 1 : step;
                if (step + 1 < 32) MC_ISSUE((step + 1) & 1, step + 1);
                const u32x4 nwg = *(const u32x4*)(wg_src + sn * 128); f32x4 ncw = {0.f, 0.f, 0.f, 0.f}; if (tid < 160) ncw = *(const f32x4*)(cw_src + sn * 128);
                if (step + 1 < 32) asm volatile("s_waitcnt vmcnt(6)" ::: "memory");
                else asm volatile("s_waitcnt vmcnt(0)" ::: "memory");
                __syncthreads();
                const LAS unsigned char* im = img0 + (step & 1) * 40960;
                const LAS bf16_t* gwb = l_gw + (step & 1) * 4352; const LAS float* cwb = l_cwb + (step & 1) * 640;
#pragma unroll
                for (int q = 0; q < 4; ++q) {
                    const int gl = chh * 4 + q, ch = step * 128 + 16 * gl + 8 * hh, cc = 2 * gl + hh;
                    const int i0 = 29 + lr;
                    const u32x4 c0 = ok0 ? *(const LAS u32x4*)(im + (i0) * 256 + ((cc ^ ((i0) & 15)) * 16)) : zz4;
                    const u32x4 c1 = ok1 ? *(const LAS u32x4*)(im + (i0 + 1) * 256 + ((cc ^ ((i0 + 1) & 15)) * 16)) : zz4;
                    const u32x4 c2 = ok2 ? *(const LAS u32x4*)(im + (i0 + 2) * 256 + ((cc ^ ((i0 + 2) & 15)) * 16)) : zz4;
                    const u32x4 c3 = *(const LAS u32x4*)(im + (i0 + 3) * 256 + ((cc ^ ((i0 + 3) & 15)) * 16));
                    float w0[8], w1[8], w2[8], w3[8], xc[8];
                    unpack8(c0, w0); unpack8(c1, w1); unpack8(c2, w2); unpack8(c3, w3);
#pragma unroll
                    for (int q4 = 0; q4 < 2; ++q4) {
                        const int cl = 16 * gl + 8 * hh + 4 * q4;
                        const f32x4 k0 = *(const LAS f32x4*)(cwb + cl), k1 = *(const LAS f32x4*)(cwb + 128 + cl), k2 = *(const LAS f32x4*)(cwb + 256 + cl), k3 = *(const LAS f32x4*)(cwb + 384 + cl);
                        const f32x4 bb = *(const LAS f32x4*)(cwb + 512 + cl);
#pragma unroll
                        for (int e = 0; e < 4; ++e) xc[4 * q4 + e] = silu_f(bb[e] + w0[4 * q4 + e] * k0[e] + w1[4 * q4 + e] * k1[e] + w2[4 * q4 + e] * k2[e] + w3[4 * q4 + e] * k3[e]);
                    }
                    const u32x4 xh = pack8f(xc);
                    *(u32x4*)(XC + trow * 4096 + ch) = xh;
                    float xr[8], xhf[8]; unpack8(xh, xhf);
#pragma unroll
                    for (int e = 0; e < 8; ++e) xr[e] = xc[e] - xhf[e];
                    const u32x4 xl = pack8f(xr);
                    const int wo = (r & 7) * 136 + 16 * gl + 8 * hh;
                    bf16x8 bch = *(const LAS bf16x8*)(gwb + wo), bcl = *(const LAS bf16x8*)(gwb + 8 * 136 + wo), bmh = *(const LAS bf16x8*)(gwb + 16 * 136 + wo), bml = *(const LAS bf16x8*)(gwb + 24 * 136 + wo);
                    if (r >= 8) { bch = bcl = bmh = bml = (bf16x8){0, 0, 0, 0, 0, 0, 0, 0}; }
                    const bf16x8 ah = __builtin_bit_cast(bf16x8, xh), al = __builtin_bit_cast(bf16x8, xl), am = __builtin_bit_cast(bf16x8, c3);
                    acc = MFMA32(ah, bch, acc); acc = MFMA32(ah, bcl, acc); acc = MFMA32(al, bch, acc); acc = MFMA32(am, bmh, acc); acc = MFMA32(am, bml, acc);
                }
                { const int nb = (step + 1) & 1; *(LAS u32x4*)(l_gw + nb * 4352 + (wg_arr * 8 + wg_row) * 136 + wg_ch * 8) = nwg; if (tid < 160) *(LAS f32x4*)(l_cwb + nb * 640 + (tid >> 5) * 128 + (tid & 31) * 4) = ncw; }
                __syncthreads();
            }
#undef MC_ISSUE
            if (r < 8) {
#pragma unroll
                for (int i = 0; i < 16; ++i) l_gp[(chh * 128 + 32 * rb + crow(i, hh)) * 8 + r] = acc[i];
            }
            __syncthreads();
            if (tid < 128) {
#pragma unroll
                for (int g = 0; g < 8; ++g) { const float sg = (l_gp[tid * 8 + g] + l_gp[(128 + tid) * 8 + g]) + p.in[14][g];
                    if (g < 4) l_ig[g * 128 + tid] = sg; else l_lf[(g - 4) * 128 + tid] = fminf(sg, 0.f) - log1pf(__expf(-fabsf(sg))); }
            }
            __syncthreads();
            if (wave < 4) {
                const int h = wave; const float f0 = l_lf[h * 128 + 2 * lane], f1 = l_lf[h * 128 + 2 * lane + 1];
                float x = f0 + f1;
#pragma unroll
                for (int d = 1; d < 64; d <<= 1) { const float v = __shfl_up(x, d); if (lane >= d) x += v; }
                const float b1 = x, b0 = x - f1;
                const float a0 = l_ig[h * 128 + 2 * lane] - b0, a1 = l_ig[h * 128 + 2 * lane + 1] - b1;
                float mx = fmaxf(a0, a1);
#pragma unroll
                for (int d = 1; d < 64; d <<= 1) { const float v = __shfl_up(mx, d); if (lane >= d) mx = fmaxf(mx, v); }
                float mprev = __shfl_up(mx, 1); if (lane == 0) mprev = -INFINITY;
                const float pm0 = fmaxf(mprev, a0), pm1 = mx;
                const size_t o0 = (row0 + 2 * lane) * 4 + h, o1 = o0 + 4;
                GB[o0] = b0; GB[o1] = b1; GA[o0] = a0; GA[o1] = a1; GPM[o0] = pm0; GPM[o1] = pm1;
                if (lane == 63) { BL[cb * 4 + h] = b1; PL[cb * 4 + h] = pm1; }
            }
            __syncthreads();
        }
    }
#if (REP_MASK >> 9) & 1
    grid.sync();
    if (IN(PH_MC)) {
        const bf16_t* XM = (const bf16_t*)(ws + WS_XM); bf16_t* XC = (bf16_t*)(ws + WS_XC);
        const bf16_t* wch = (const bf16_t*)(ws + WS_WGC); const bf16_t* wcl = wch + 32768; const bf16_t* wmh = (const bf16_t*)(ws + WS_WGM); const bf16_t* wml = wmh + 32768;
        float* GA = (float*)(ws + WS_GA); float* GPM = (float*)(ws + WS_GPM); float* GB = (float*)(ws + WS_GB); float* BL = (float*)(ws + WS_BLAST); float* PL = (float*)(ws + WS_PML);
        LAS unsigned char* img0 = lds;
        LAS float* l_gp = (LAS float*)(lds + 81920);
        LAS float* l_ig = l_gp + 2048;
        LAS float* l_lf = l_ig + 512;
        const int r = lane & 31, hh = lane >> 5, rb = wave & 3, chh = wave >> 2;
        const int dslot = (tid & 15) ^ ((tid >> 4) & 15);
        LAS bf16_t* l_gw = (LAS bf16_t*)(lds + 94208); LAS float* l_cwb = (LAS float*)(lds + 94208 + 2 * 8704);
        const int wg_arr = tid >> 7, wg_row = (tid >> 4) & 7, wg_ch = tid & 15;
        const bf16_t* wg_src = (wg_arr == 0 ? wch : wg_arr == 1 ? wcl : wg_arr == 2 ? wmh : wml) + (size_t)wg_row * 4096 + wg_ch * 8;
        const float* cw_src = (tid < 128 ? p.in[8] + (size_t)(tid >> 5) * 4096 : p.in[9]) + (tid & 31) * 4;
        for (int cb = blockIdx.x; cb < NCB; cb += G) {
            const size_t row0 = (size_t)cb * 128; const bool first = (cb & 127) == 0;
            const int lr = 32 * rb + r; const size_t trow = row0 + lr;
            const bool ok0 = !first || lr >= 3, ok1 = !first || lr >= 2, ok2 = !first || lr >= 1;
            const bf16_t* dma_lo = XM + (first ? row0 + (size_t)(tid >> 4) : row0 - 32 + (size_t)(tid >> 4)) * 4096 + dslot * 8;
            const bf16_t* dma_hi = XM + (row0 + (size_t)(tid >> 4)) * 4096 + dslot * 8;
#define MC_ISSUE(bufi, stp) do { LAS unsigned char* d_ = img0 + (bufi) * 40960 + wave * 1024; \
            __builtin_amdgcn_global_load_lds((const unsigned*)(dma_lo + (stp) * 128), (LAS unsigned*)d_, 16, 0, 0); \
            _Pragma("unroll") for (int j_ = 0; j_ < 4; ++j_) __builtin_amdgcn_global_load_lds((const unsigned*)(dma_hi + (size_t)j_ * 32 * 4096 + (stp) * 128), (LAS unsigned*)(d_ + (j_ + 1) * 8192), 16, 0, 0); } while (0)
            f32x16 acc;
#pragma unroll
            for (int i = 0; i < 16; ++i) acc[i] = 0.f;
            const u32x4 zz4 = {0u, 0u, 0u, 0u};
            MC_ISSUE(0, 0);
            { *(LAS u32x4*)(l_gw + (wg_arr * 8 + wg_row) * 136 + wg_ch * 8) = *(const u32x4*)wg_src; if (tid < 160) *(LAS f32x4*)(l_cwb + (tid >> 5) * 128 + (tid & 31) * 4) = *(const f32x4*)cw_src; }
#pragma unroll 1
            for (int step = 0; step < 32; ++step) {
                const int sn = step + 1 < 32 ? step + 1 : step;
                if (step + 1 < 32) MC_ISSUE((step + 1) & 1, step + 1);
                const u32x4 nwg = *(const u32x4*)(wg_src + sn * 128); f32x4 ncw = {0.f, 0.f, 0.f, 0.f}; if (tid < 160) ncw = *(const f32x4*)(cw_src + sn * 128);
                if (step + 1 < 32) asm volatile("s_waitcnt vmcnt(6)" ::: "memory");
                else asm volatile("s_waitcnt vmcnt(0)" ::: "memory");
                __syncthreads();
                const LAS unsigned char* im = img0 + (step & 1) * 40960;
                const LAS bf16_t* gwb = l_gw + (step & 1) * 4352; const LAS float* cwb = l_cwb + (step & 1) * 640;
#pragma unroll
                for (int q = 0; q < 4; ++q) {
                    const int gl = chh * 4 + q, ch = step * 128 + 16 * gl + 8 * hh, cc = 2 * gl + hh;
                    const int i0 = 29 + lr;
                    const u32x4 c0 = ok0 ? *(const LAS u32x4*)(im + (i0) * 256 + ((cc ^ ((i0) & 15)) * 16)) : zz4;
                    const u32x4 c1 = ok1 ? *(const LAS u32x4*)(im + (i0 + 1) * 256 + ((cc ^ ((i0 + 1) & 15)) * 16)) : zz4;
                    const u32x4 c2 = ok2 ? *(const LAS u32x4*)(im + (i0 + 2) * 256 + ((cc ^ ((i0 + 2) & 15)) * 16)) : zz4;
                    const u32x4 c3 = *(const LAS u32x4*)(im + (i0 + 3) * 256 + ((cc ^ ((i0 + 3) & 15)) * 16));
                    float w0[8], w1[8], w2[8], w3[8], xc[8];
                    unpack8(c0, w0); unpack8(c1, w1); unpack8(c2, w2); unpack8(c3, w3);
#pragma unroll
                    for (int q4 = 0; q4 < 2; ++q4) {
                        const int cl = 16 * gl + 8 * hh + 4 * q4;
                        const f32x4 k0 = *(const LAS f32x4*)(cwb + cl), k1 = *(const LAS f32x4*)(cwb + 128 + cl), k2 = *(const LAS f32x4*)(cwb + 256 + cl), k3 = *(const LAS f32x4*)(cwb + 384 + cl);
                        const f32x4 bb = *(const LAS f32x4*)(cwb + 512 + cl);
#pragma unroll
                        for (int e = 0; e < 4; ++e) xc[4 * q4 + e] = silu_f(bb[e] + w0[4 * q4 + e] * k0[e] + w1[4 * q4 + e] * k1[e] + w2[4 * q4 + e] * k2[e] + w3[4 * q4 + e] * k3[e]);
                    }
                    const u32x4 xh = pack8f(xc);
                    *(u32x4*)(XC + trow * 4096 + ch) = xh;
                    float xr[8], xhf[8]; unpack8(xh, xhf);
#pragma unroll
                    for (int e = 0; e < 8; ++e) xr[e] = xc[e] - xhf[e];
                    const u32x4 xl = pack8f(xr);
                    const int wo = (r & 7) * 136 + 16 * gl + 8 * hh;
                    bf16x8 bch = *(const LAS bf16x8*)(gwb + wo), bcl = *(const LAS bf16x8*)(gwb + 8 * 136 + wo), bmh = *(const LAS bf16x8*)(gwb + 16 * 136 + wo), bml = *(const LAS bf16x8*)(gwb + 24 * 136 + wo);
                    if (r >= 8) { bch = bcl = bmh = bml = (bf16x8){0, 0, 0, 0, 0, 0, 0, 0}; }
                    const bf16x8 ah = __builtin_bit_cast(bf16x8, xh), al = __builtin_bit_cast(bf16x8, xl), am = __builtin_bit_cast(bf16x8, c3);
                    acc = MFMA32(ah, bch, acc); acc = MFMA32(ah, bcl, acc); acc = MFMA32(al, bch, acc); acc = MFMA32(am, bmh, acc); acc = MFMA32(am, bml, acc);
                }
                { const int nb = (step + 1) & 1; *(LAS u32x4*)(l_gw + nb * 4352 + (wg_arr * 8 + wg_row) * 136 + wg_ch * 8) = nwg; if (tid < 160) *(LAS f32x4*)(l_cwb + nb * 640 + (tid >> 5) * 128 + (tid & 31) * 4) = ncw; }
                __syncthreads();
            }
#undef MC_ISSUE
            if (r < 8) {
#pragma unroll
                for (int i = 0; i < 16; ++i) l_gp[(chh * 128 + 32 * rb + crow(i, hh)) * 8 + r] = acc[i];
            }
            __syncthreads();
            if (tid < 128) {
#pragma unroll
                for (int g = 0; g < 8; ++g) { const float sg = (l_gp[tid * 8 + g] + l_gp[(128 + tid) * 8 + g]) + p.in[14][g];
                    if (g < 4) l_ig[g * 128 + tid] = sg; else l_lf[(g - 4) * 128 + tid] = fminf(sg, 0.f) - log1pf(__expf(-fabsf(sg))); }
            }
            __syncthreads();
            if (wave < 4) {
                const int h = wave; const float f0 = l_lf[h * 128 + 2 * lane], f1 = l_lf[h * 128 + 2 * lane + 1];
                float x = f0 + f1;
#pragma unroll
                for (int d = 1; d < 64; d <<= 1) { const float v = __shfl_up(x, d); if (lane >= d) x += v; }
                const float b1 = x, b0 = x - f1;
                const float a0 = l_ig[h * 128 + 2 * lane] - b0, a1 = l_ig[h * 128 + 2 * lane + 1] - b1;
                float mx = fmaxf(a0, a1);
#pragma unroll
                for (int d = 1; d < 64; d <<= 1) { const float v = __shfl_up(mx, d); if (lane >= d) mx = fmaxf(mx, v); }
                float mprev = __shfl_up(mx, 1); if (lane == 0) mprev = -INFINITY;
                const float pm0 = fmaxf(mprev, a0), pm1 = mx;
                const size_t o0 = (row0 + 2 * lane) * 4 + h, o1 = o0 + 4;
                GB[o0] = b0; GB[o1] = b1; GA[o0] = a0; GA[o1] = a1; GPM[o0] = pm0; GPM[o1] = pm1;
                if (lane == 63) { BL[cb * 4 + h] = b1; PL[cb * 4 + h] = pm1; }
            }
            __syncthreads();
        }
    }
#endif
    SEAM(PH_MC);
    if (IN(PH_MP)) {
        phase_scores<32, true>((const bf16_t*)(ws + WS_XC), (const bf16_t*)(ws + WS_XC), 4096, nullptr, (const u32x2*)(ws + WS_BDQC), (const u32x2*)(ws + WS_BDKC), 4, (bf16_t*)(dob + DO_PML1),
                               (const float*)(ws + WS_GA), (const float*)(ws + WS_GPM), (const float*)(ws + WS_GB), (const float*)(ws + WS_BLAST), (const float*)(ws + WS_PML), (float*)(ws + WS_DENA), (float*)(ws + WS_EMT), (float*)(ws + WS_DENI), (float*)(dob + DO_INTER2), (float*)(ws + WS_CW), (float*)(ws + WS_DEC), (float*)(dob + DO_KW), lds);
    }
#if (REP_MASK >> 10) & 1
    grid.sync();
    if (IN(PH_MP)) {
        phase_scores<32, true>((const bf16_t*)(ws + WS_XC), (const bf16_t*)(ws + WS_XC), 4096, nullptr, (const u32x2*)(ws + WS_BDQC), (const u32x2*)(ws + WS_BDKC), 4, (bf16_t*)(dob + DO_PML1),
                               (const float*)(ws + WS_GA), (const float*)(ws + WS_GPM), (const float*)(ws + WS_GB), (const float*)(ws + WS_BLAST), (const float*)(ws + WS_PML), (float*)(ws + WS_DENA), (float*)(ws + WS_EMT), (float*)(ws + WS_DENI), (float*)(dob + DO_INTER2), (float*)(ws + WS_CW), (float*)(ws + WS_DEC), (float*)(dob + DO_KW), lds);
    }
#endif
    SEAM(PH_MP);
    if (IN(PH_MS)) {
        { const float* KW = (const float*)(dob + DO_KW); float* NPV = (float*)(dob + DO_NPREV); const float* DEC = (const float*)(ws + WS_DEC);
            for (int idx = (int)gtid; idx < 8192; idx += (int)gthreads) { const int bh = idx >> 10, dk = idx & 1023, b = bh >> 2, h = bh & 3; float nv = 0.f;
#pragma unroll 8
                for (int c = 0; c < 128; ++c) { const size_t o = (size_t)((b * 128 + c) * 4 + h) * 1024 + dk; NPV[o] = nv; nv = DEC[(b * 128 + c) * 4 + h] * nv + KW[o]; } } }
        phase_scan<4, true>((const bf16_t*)(ws + WS_XC), (const bf16_t*)(ws + WS_XC), 4096, (const bf16_t*)(ws + WS_BDQ), (const bf16_t*)(ws + WS_BDK), 4, 1024, (bf16_t*)(ws + WS_XM), (const bf16_t*)(dob + DO_PML1),
                            p.in[12], (const float*)(ws + WS_DENI), (const float*)(dob + DO_INTER2), (const float*)(ws + WS_CW), (const float*)(ws + WS_DEC), lds, !((REP_MASK >> 11) & 1));
    }
#if (REP_MASK >> 11) & 1
    grid.sync();
    if (IN(PH_MS)) {
        { const float* KW = (const float*)(dob + DO_KW); float* NPV = (float*)(dob + DO_NPREV); const float* DEC = (const float*)(ws + WS_DEC);
            for (int idx = (int)gtid; idx < 8192; idx += (int)gthreads) { const int bh = idx >> 10, dk = idx & 1023, b = bh >> 2, h = bh & 3; float nv = 0.f;
#pragma unroll 8
                for (int c = 0; c < 128; ++c) { const size_t o = (size_t)((b * 128 + c) * 4 + h) * 1024 + dk; NPV[o] = nv; nv = DEC[(b * 128 + c) * 4 + h] * nv + KW[o]; } } }
        phase_scan<4, true>((const bf16_t*)(ws + WS_XC), (const bf16_t*)(ws + WS_XC), 4096, (const bf16_t*)(ws + WS_BDQ), (const bf16_t*)(ws + WS_BDK), 4, 1024, (bf16_t*)(ws + WS_XM), (const bf16_t*)(dob + DO_PML1),
                            p.in[12], (const float*)(ws + WS_DENI), (const float*)(dob + DO_INTER2), (const float*)(ws + WS_CW), (const float*)(ws + WS_DEC), lds);
    }
#endif
    SEAM(PH_MS);
    if (IN(PH_MF)) {
        const bf16_t* O = (const bf16_t*)(ws + WS_XM); bf16_t* Zt = (bf16_t*)(ws + WS_Z); const bf16_t* XC = (const bf16_t*)(ws + WS_XC);
        const float* dena = (const float*)(ws + WS_DENA); const float* deni = (const float*)(ws + WS_DENI); const float* emt = (const float*)(ws + WS_EMT);
        const float* gn = p.in[15]; const float* sk = p.in[16];
        const float* NPV = (const float*)(dob + DO_NPREV);
        {
            const int h = gw & 3;
            f32x4 wq4[2][8];
#pragma unroll
            for (int k = 0; k < 2; ++k) { const int c = h * 1024 + k * 512 + lane * 8;
#pragma unroll
                for (int j = 0; j < 8; ++j) wq4[k][j] = *((const f32x4*)(p.in[10] + (size_t)(c >> 2) * 16) + j);
            }
            const bool mf_store_ = ((REP_MASK >> 12) & 1) ? (mf_pass_++ > 0) : true;
            const int nrw_ = (T + (ngw >> 2) - 1) / (ngw >> 2), rowA_ = (gw >> 2) * nrw_;
            const int rowA = rowA_ < T ? rowA_ : T - 1, nrw = rowA_ >= T ? 0 : (rowA_ + nrw_ <= T ? nrw_ : T - rowA_);
            const size_t cbase = (size_t)h * 1024 + lane * 8;
            f32x4 nv[2][2];
#pragma unroll
            for (int k = 0; k < 2; ++k) { const f32x4* np4 = (const f32x4*)(NPV + (size_t)((rowA >> 7) * 4 + h) * 1024 + k * 512 + lane * 8); nv[k][0] = np4[0]; nv[k][1] = np4[1]; }
            u32x4 nxc[2], nxo[2], nxz[2]; float nda, ndi, nem;
#pragma unroll
            for (int k = 0; k < 2; ++k) { const size_t off = (size_t)rowA * 4096 + cbase + k * 512; nxc[k] = *(const u32x4*)(XC + off); nxo[k] = *(const u32x4*)(O + off); nxz[k] = *(const u32x4*)(Zt + off); }
            nda = dena[(size_t)rowA * 4 + h]; ndi = deni[(size_t)rowA * 4 + h]; nem = emt[(size_t)rowA * 4 + h];
#pragma unroll 1
            for (int ri = 0; ri < nrw; ++ri) {
                const int row = rowA + ri, rown = ri + 1 < nrw ? row + 1 : row;
                if (((row & 127) == 0) && ri) {
#pragma unroll
                    for (int k = 0; k < 2; ++k) { const f32x4* np4 = (const f32x4*)(NPV + (size_t)((row >> 7) * 4 + h) * 1024 + k * 512 + lane * 8); nv[k][0] = np4[0]; nv[k][1] = np4[1]; }
                }
                const u32x4 cxc0 = nxc[0], cxc1 = nxc[1], cxo0 = nxo[0], cxo1 = nxo[1], cxz0 = nxz[0], cxz1 = nxz[1]; const float cda = nda, cdi = ndi, cem = nem;
#pragma unroll
                for (int k = 0; k < 2; ++k) { const size_t off = (size_t)rown * 4096 + cbase + k * 512; nxc[k] = *(const u32x4*)(XC + off); nxo[k] = *(const u32x4*)(O + off); nxz[k] = *(const u32x4*)(Zt + off); }
                nda = dena[(size_t)rown * 4 + h]; ndi = deni[(size_t)rown * 4 + h]; nem = emt[(size_t)rown * 4 + h];
                float x8[2][8], o[16], qn = 0.f;
#pragma unroll
                for (int k = 0; k < 2; ++k) {
                    unpack8(k ? cxc1 : cxc0, x8[k]);
#pragma unroll
                    for (int bl = 0; bl < 2; ++bl)
#pragma unroll
                        for (int oo = 0; oo < 4; ++oo) { const f32x4 w4 = wq4[k][bl * 4 + oo];
                            const float qv = w4[0] * x8[k][4 * bl] + w4[1] * x8[k][4 * bl + 1] + w4[2] * x8[k][4 * bl + 2] + w4[3] * x8[k][4 * bl + 3];
                            qn += qv * nv[k][bl][oo]; }
                    float t8[8]; unpack8(k ? cxo1 : cxo0, t8);
#pragma unroll
                    for (int e2 = 0; e2 < 8; ++e2) o[8 * k + e2] = t8[e2];
                }
                qn = wave_sum(qn);
                const float den = cda + cdi * qn;
                const float inv = 1.0f / fmaxf(fabsf(den), cem);
                float sm = 0.f;
#pragma unroll
                for (int e2 = 0; e2 < 16; ++e2) { o[e2] *= inv; sm += o[e2]; }
                const float mu = wave_sum(sm) * (1.f / 1024.f); float q = 0.f;
#pragma unroll
                for (int e2 = 0; e2 < 16; ++e2) { o[e2] -= mu; q += o[e2] * o[e2]; }
                const float rstd = rsqrtf(wave_sum(q) * (1.f / 1024.f) + EPSN);
#pragma unroll
                for (int k = 0; k < 2; ++k) {
                    const int c = h * 1024 + k * 512 + lane * 8; const size_t off = (size_t)row * 4096 + c;
                    float z8[8], y[8]; unpack8(k ? cxz1 : cxz0, z8);
                    const f32x4 g0 = *(const f32x4*)(gn + c), g1 = *(const f32x4*)(gn + c + 4), s0 = *(const f32x4*)(sk + c), s1 = *(const f32x4*)(sk + c + 4);
#pragma unroll
                    for (int e2 = 0; e2 < 8; ++e2) y[e2] = (o[8 * k + e2] * rstd * (e2 < 4 ? g0[e2 & 3] : g1[e2 & 3]) + (e2 < 4 ? s0[e2 & 3] : s1[e2 & 3]) * x8[k][e2]) * silu_f(z8[e2]);
                    if (mf_store_) *(u32x4*)(Zt + off) = pack8f(y);
                }
            }
        }
    }
#if (REP_MASK >> 12) & 1
    grid.sync();
    if (IN(PH_MF)) {
        const bf16_t* O = (const bf16_t*)(ws + WS_XM); bf16_t* Zt = (bf16_t*)(ws + WS_Z); const bf16_t* XC = (const bf16_t*)(ws + WS_XC);
        const float* dena = (const float*)(ws + WS_DENA); const float* deni = (const float*)(ws + WS_DENI); const float* emt = (const float*)(ws + WS_EMT);
        const float* gn = p.in[15]; const float* sk = p.in[16];
        const float* NPV = (const float*)(dob + DO_NPREV);
        {
            const int h = gw & 3;
            f32x4 wq4[2][8];
#pragma unroll
            for (int k = 0; k < 2; ++k) { const int c = h * 1024 + k * 512 + lane * 8;
#pragma unroll
                for (int j = 0; j < 8; ++j) wq4[k][j] = *((const f32x4*)(p.in[10] + (size_t)(c >> 2) * 16) + j);
            }
            const bool mf_store_ = ((REP_MASK >> 12) & 1) ? (mf_pass_++ > 0) : true;
            const int nrw_ = (T + (ngw >> 2) - 1) / (ngw >> 2), rowA_ = (gw >> 2) * nrw_;
            const int rowA = rowA_ < T ? rowA_ : T - 1, nrw = rowA_ >= T ? 0 : (rowA_ + nrw_ <= T ? nrw_ : T - rowA_);
            const size_t cbase = (size_t)h * 1024 + lane * 8;
            f32x4 nv[2][2];
#pragma unroll
            for (int k = 0; k < 2; ++k) { const f32x4* np4 = (const f32x4*)(NPV + (size_t)((rowA >> 7) * 4 + h) * 1024 + k * 512 + lane * 8); nv[k][0] = np4[0]; nv[k][1] = np4[1]; }
            u32x4 nxc[2], nxo[2], nxz[2]; float nda, ndi, nem;
#pragma unroll
            for (int k = 0; k < 2; ++k) { const size_t off = (size_t)rowA * 4096 + cbase + k * 512; nxc[k] = *(const u32x4*)(XC + off); nxo[k] = *(const u32x4*)(O + off); nxz[k] = *(const u32x4*)(Zt + off); }
            nda = dena[(size_t)rowA * 4 + h]; ndi = deni[(size_t)rowA * 4 + h]; nem = emt[(size_t)rowA * 4 + h];
#pragma unroll 1
            for (int ri = 0; ri < nrw; ++ri) {
                const int row = rowA + ri, rown = ri + 1 < nrw ? row + 1 : row;
                if (((row & 127) == 0) && ri) {
#pragma unroll
                    for (int k = 0; k < 2; ++k) { const f32x4* np4 = (const f32x4*)(NPV + (size_t)((row >> 7) * 4 + h) * 1024 + k * 512 + lane * 8); nv[k][0] = np4[0]; nv[k][1] = np4[1]; }
                }
                const u32x4 cxc0 = nxc[0], cxc1 = nxc[1], cxo0 = nxo[0], cxo1 = nxo[1], cxz0 = nxz[0], cxz1 = nxz[1]; const float cda = nda, cdi = ndi, cem = nem;
#pragma unroll
                for (int k = 0; k < 2; ++k) { const size_t off = (size_t)rown * 4096 + cbase + k * 512; nxc[k] = *(const u32x4*)(XC + off); nxo[k] = *(const u32x4*)(O + off); nxz[k] = *(const u32x4*)(Zt + off); }
                nda = dena[(size_t)rown * 4 + h]; ndi = deni[(size_t)rown * 4 + h]; nem = emt[(size_t)rown * 4 + h];
                float x8[2][8], o[16], qn = 0.f;
#pragma unroll
                for (int k = 0; k < 2; ++k) {
                    unpack8(k ? cxc1 : cxc0, x8[k]);
#pragma unroll
                    for (int bl = 0; bl < 2; ++bl)
#pragma unroll
                        for (int oo = 0; oo < 4; ++oo) { const f32x4 w4 = wq4[k][bl * 4 + oo];
                            const float qv = w4[0] * x8[k][4 * bl] + w4[1] * x8[k][4 * bl + 1] + w4[2] * x8[k][4 * bl + 2] + w4[3] * x8[k][4 * bl + 3];
                            qn += qv * nv[k][bl][oo]; }
                    float t8[8]; unpack8(k ? cxo1 : cxo0, t8);
#pragma unroll
                    for (int e2 = 0; e2 < 8; ++e2) o[8 * k + e2] = t8[e2];
                }
                qn = wave_sum(qn);
                const float den = cda + cdi * qn;
                const float inv = 1.0f / fmaxf(fabsf(den), cem);
                float sm = 0.f;
#pragma unroll
                for (int e2 = 0; e2 < 16; ++e2) { o[e2] *= inv; sm += o[e2]; }
                const float mu = wave_sum(sm) * (1.f / 1024.f); float q = 0.f;
#pragma unroll
                for (int e2 = 0; e2 < 16; ++e2) { o[e2] -= mu; q += o[e2] * o[e2]; }
                const float rstd = rsqrtf(wave_sum(q) * (1.f / 1024.f) + EPSN);
#pragma unroll
                for (int k = 0; k < 2; ++k) {
                    const int c = h * 1024 + k * 512 + lane * 8; const size_t off = (size_t)row * 4096 + c;
                    float z8[8], y[8]; unpack8(k ? cxz1 : cxz0, z8);
                    const f32x4 g0 = *(const f32x4*)(gn + c), g1 = *(const f32x4*)(gn + c + 4), s0 = *(const f32x4*)(sk + c), s1 = *(const f32x4*)(sk + c + 4);
#pragma unroll
                    for (int e2 = 0; e2 < 8; ++e2) y[e2] = (o[8 * k + e2] * rstd * (e2 < 4 ? g0[e2 & 3] : g1[e2 & 3]) + (e2 < 4 ? s0[e2 & 3] : s1[e2 & 3]) * x8[k][e2]) * silu_f(z8[e2]);
                    if (mf_store_) *(u32x4*)(Zt + off) = pack8f(y);
                }
            }
        }
    }
#endif
    SEAM(PH_MF);
    if (IN(PH_G6)) {
        pg8::Gemm g{(const bf16_t*)(ws + WS_Z), (const bf16_t*)(ws + WS_WT6), T, DM, 4096}; pg8::StaticOrder S; S.init(T, DM, G, (int)blockIdx.x);
        EpiResid E{hb, sumsq + 3 * T};
        pg8::gemm_phase(lds, g, S, E);
    }
#if (REP_MASK >> 13) & 1
    grid.sync();
    if (IN(PH_G6)) {
        pg8::Gemm g{(const bf16_t*)(ws + WS_Z), (const bf16_t*)(ws + WS_WT6), T, DM, 4096}; pg8::StaticOrder S; S.init(T, DM, G, (int)blockIdx.x);
        EpiResid E{hb, sumsq + 3 * T};
        pg8::gemm_phase(lds, g, S, E);
    }
#endif
    SEAM(PH_G6);
    if (IN(PH_G7)) {
        pg8::Gemm g{hb, (const bf16_t*)(ws + WS_WT7), T, 2 * FF, DM}; pg8::StaticOrder S; S.init(T, 2 * FF, G, (int)blockIdx.x);
        EpiSwiGLU E{(bf16_t*)(ws + WS_ACT1), sumsq + 3 * T};
        pg8::gemm_phase(lds, g, S, E);
    }
#if (REP_MASK >> 14) & 1
    grid.sync();
    if (IN(PH_G7)) {
        pg8::Gemm g{hb, (const bf16_t*)(ws + WS_WT7), T, 2 * FF, DM}; pg8::StaticOrder S; S.init(T, 2 * FF, G, (int)blockIdx.x);
        EpiSwiGLU E{(bf16_t*)(ws + WS_ACT1), sumsq + 3 * T};
        pg8::gemm_phase(lds, g, S, E);
    }
#endif
    SEAM(PH_G7);
    if (IN(PH_G8)) {
        pg8::Gemm g{(const bf16_t*)(ws + WS_ACT1), (const bf16_t*)(ws + WS_WT8), T, DM, FF}; pg8::StaticOrder S; S.init(T, DM, G, (int)blockIdx.x);
        EpiResid E{hb, sumsq + 4 * T};
        pg8::gemm_phase(lds, g, S, E);
    }
#if (REP_MASK >> 15) & 1
    grid.sync();
    if (IN(PH_G8)) {
        pg8::Gemm g{(const bf16_t*)(ws + WS_ACT1), (const bf16_t*)(ws + WS_WT8), T, DM, FF}; pg8::StaticOrder S; S.init(T, DM, G, (int)blockIdx.x);
        EpiResid E{hb, sumsq + 4 * T};
        pg8::gemm_phase(lds, g, S, E);
    }
#endif
    SEAM(PH_G8);
#ifdef EXTRA_SYNCS
    for (int q_ = 0; q_ < EXTRA_SYNCS; ++q_) grid.sync();
#endif
    if (IN(PH_FIN)) {
        const float* fg = p.in[21];
        u32x4 nh[4]; u64 nsq = 0;
        if (gw < T) { const u32x4* hr = (const u32x4*)(hb + (size_t)gw * DM);
#pragma unroll
            for (int j = 0; j < 4; ++j) nh[j] = hr[j * 64 + lane];
            nsq = sumsq[4 * T + gw]; }
        for (int m = gw; m < T; m += ngw) {
            u32x4 ch_[4]; const u64 csq = nsq;
#pragma unroll
            for (int j = 0; j < 4; ++j) ch_[j] = nh[j];
            { const int mn = m + ngw < T ? m + ngw : m; const u32x4* hr = (const u32x4*)(hb + (size_t)mn * DM);
#pragma unroll
              for (int j = 0; j < 4; ++j) nh[j] = hr[j * 64 + lane];
              nsq = sumsq[4 * T + mn]; }
            const float rs = ss_rstd(&csq, 0);
            f32x4* orow = (f32x4*)(out + (size_t)m * DM);
#pragma unroll
            for (int j = 0; j < 4; ++j) { float v[8]; unpack8(ch_[j], v);
                const f32x4 g0 = *((const f32x4*)fg + 2 * (j * 64 + lane)), g1 = *((const f32x4*)fg + 2 * (j * 64 + lane) + 1);
                orow[2 * (j * 64 + lane)] = (f32x4){v[0] * rs * g0[0], v[1] * rs * g0[1], v[2] * rs * g0[2], v[3] * rs * g0[3]};
                orow[2 * (j * 64 + lane) + 1] = (f32x4){v[4] * rs * g1[0], v[5] * rs * g1[1], v[6] * rs * g1[2], v[7] * rs * g1[3]}; }
        }
    }
#undef IN
#undef SEAM
}

#ifndef MK_PER_PHASE
#define MK_PER_PHASE 0
#endif
extern "C" void kernel_launch(void* const* d_in, const int* in_sizes, int n_in, void* d_out, int out_size, void* d_ws, size_t ws_size, hipStream_t stream) {
    static int grid = 0;
    if (grid == 0) {
        if (n_in != 22 || out_size != T * DM || ws_size < WS_END) { fprintf(stderr, "kernel_launch: unexpected shapes (n_in %d out %d ws %zu)\n", n_in, out_size, ws_size); grid = -1; return; }
        int dev = 0, cus = 0, per_cu = 0;
        (void)hipGetDevice(&dev); (void)hipDeviceGetAttribute(&cus, hipDeviceAttributeMultiprocessorCount, dev);
        if (hipFuncSetAttribute((const void*)mega, hipFuncAttributeMaxDynamicSharedMemorySize, LDS_BYTES) != hipSuccess) { fprintf(stderr, "kernel_launch: hipFuncSetAttribute failed\n"); grid = -1; return; }
        if (hipOccupancyMaxActiveBlocksPerMultiprocessor(&per_cu, (const void*)mega, 512, LDS_BYTES) != hipSuccess || per_cu < 1) { fprintf(stderr, "kernel_launch: occupancy query gave %d\n", per_cu); per_cu = 1; }
        (void)hipGetLastError();
        grid = cus * 1;
        if (grid <= 0) grid = 256;
    }
    if (grid < 0) return;
    Params p{};
    for (int i = 0; i < 22; ++i) p.in[i] = (const float*)d_in[i];
    p.out = (float*)d_out; p.ws = (unsigned char*)d_ws;
#if MK_PER_PHASE
    for (int ph = 0; ph < PH_N; ++ph) { p.ph_lo = ph; p.ph_hi = ph + 1; hipLaunchKernelGGL(mega, dim3(grid), dim3(512), LDS_BYTES, stream, p); }
#else
    p.ph_lo = 0; p.ph_hi = PH_N;
    (void)hipMemsetAsync((char*)d_ws + WS_BAR, 0, 16384, stream);
    void* args[] = {&p};
    hipError_t e = hipLaunchCooperativeKernel((const void*)mega, dim3(grid), dim3(512), args, LDS_BYTES, stream);
    if (e != hipSuccess) fprintf(stderr, "kernel_launch: cooperative launch failed: %s (grid %d)\n", hipGetErrorString(e), grid);
#endif
}
```

```cpp
#include <hip/hip_runtime.h>
#include <hip/hip_cooperative_groups.h>
#include <cstdio>
#include <cstdint>
namespace cg = cooperative_groups;

#define LAS __attribute__((address_space(3)))
typedef unsigned short bf16_t;
typedef short bf16x8 __attribute__((ext_vector_type(8)));
typedef short s16x4 __attribute__((ext_vector_type(4)));
typedef float f32x4 __attribute__((ext_vector_type(4)));
typedef float f32x2 __attribute__((ext_vector_type(2)));
typedef float f32x16 __attribute__((ext_vector_type(16)));
typedef unsigned u32x4 __attribute__((ext_vector_type(4)));
typedef unsigned u32x2 __attribute__((ext_vector_type(2)));
typedef __bf16 bf16x2_t __attribute__((ext_vector_type(2)));

constexpr int T = 32768, DM = 2048, FF = 5632, NCB = 256;
constexpr float EPSN = 1e-6f;
constexpr size_t MiB = 1u << 20;
constexpr size_t WS_SUMSQ = 6 * MiB;
constexpr size_t WS_MISC = 1 * MiB;
constexpr size_t WS_BDQ = WS_MISC;
constexpr size_t WS_BDK = WS_BDQ + 262144;
constexpr size_t WS_IDT = WS_BDK + 262144;
constexpr size_t WS_WGC = WS_IDT + 4096;
constexpr size_t WS_WGM = WS_WGC + 131072;
constexpr size_t WS_GA = WS_WGM + 131072;
constexpr size_t WS_GPM = WS_GA + 524288;
constexpr size_t WS_GB = WS_GPM + 524288;
constexpr size_t WS_DENA = WS_GB + 524288;
constexpr size_t WS_DENI = WS_DENA + 524288;
constexpr size_t WS_EMT = WS_DENI + 524288;
constexpr size_t WS_BLAST = WS_EMT + 524288;
constexpr size_t WS_PML = WS_BLAST + 4096;
constexpr size_t WS_DEC = WS_PML + 4096;
constexpr size_t WS_CW = WS_DEC + 4096;
constexpr size_t WS_BDQC = 5 * MiB + 512 * 1024;
constexpr size_t WS_BDKC = WS_BDQC + 32768;
static_assert(WS_CW + 524288 <= WS_BDQC && WS_BDKC + 32768 <= 6 * MiB, "misc");
constexpr size_t WS_BAR = 7 * MiB + 512 * 1024;
constexpr size_t WS_RA = 8 * MiB;
constexpr size_t WS_RB = 136 * MiB;
constexpr size_t WS_RC = 904 * MiB;
constexpr size_t WS_END = 1024 * MiB;
constexpr size_t WS_Q = WS_RB, WS_K = WS_RB + 128 * MiB, WS_V = WS_RB + 256 * MiB, WS_G = WS_RB + 512 * MiB;
constexpr size_t WS_Y = WS_RB;
constexpr size_t WS_ACT0 = WS_RB + 256 * MiB;
constexpr size_t WS_WT2 = WS_RC, WS_WT3 = WS_RC + 16 * MiB, WS_WT4 = WS_RC + 60 * MiB;
constexpr size_t WS_WT5 = WS_RB + 608 * MiB;
constexpr size_t WS_XM = WS_RB, WS_Z = WS_RB + 256 * MiB, WS_XC = WS_RB + 512 * MiB;
constexpr size_t WS_PML1 = WS_RA;
constexpr size_t WS_KW = WS_RA + 32 * MiB;
constexpr size_t WS_NPREV = WS_RA + 36 * MiB;
constexpr size_t WS_INTER2 = WS_RA + 40 * MiB;
constexpr size_t WS_WT6 = WS_RC, WS_WT7 = WS_RC + 16 * MiB, WS_WT8 = WS_RC + 60 * MiB;
constexpr size_t WS_ACT1 = WS_RB;
constexpr size_t DO_WT1 = 0, DO_CS = 48 * MiB, DO_P0 = 80 * MiB;
constexpr size_t DO_PML1 = 0, DO_KW = 32 * MiB, DO_NPREV = 36 * MiB, DO_INTER2 = 40 * MiB;

struct Params {
    const float* in[22];
    float* out;
    unsigned char* ws;
    int ph_lo, ph_hi;
};

__device__ __forceinline__ unsigned pk2(float lo, float hi) { f32x2 v = {lo, hi}; return __builtin_bit_cast(unsigned, __builtin_convertvector(v, bf16x2_t)); }
__device__ __forceinline__ float bflo(unsigned u) { return __uint_as_float(u << 16); }
__device__ __forceinline__ float bfhi(unsigned u) { return __uint_as_float(u & 0xffff0000u); }
__device__ __forceinline__ void unpack8(const u32x4 v, float (&f)[8]) { f[0] = bflo(v.x); f[1] = bfhi(v.x); f[2] = bflo(v.y); f[3] = bfhi(v.y); f[4] = bflo(v.z); f[5] = bfhi(v.z); f[6] = bflo(v.w); f[7] = bfhi(v.w); }
__device__ __forceinline__ u32x4 pack8f(const float (&f)[8]) { u32x4 o; o.x = pk2(f[0], f[1]); o.y = pk2(f[2], f[3]); o.z = pk2(f[4], f[5]); o.w = pk2(f[6], f[7]); return o; }
__device__ __forceinline__ float wave_sum(float v) {
#pragma unroll
    for (int o = 1; o < 64; o <<= 1) v += __shfl_xor(v, o);
    return v;
}
typedef unsigned long long u64;
__device__ __forceinline__ u64 ss_fix(float s) { return (u64)((double)s * 16777216.0); }
__device__ __forceinline__ float ss_rstd(const u64* p, int row) { return rsqrtf((float)((double)p[row] * (1.0 / 16777216.0 / 2048.0)) + EPSN); }
__device__ __forceinline__ float silu_f(float x) { return x * __frcp_rn(1.0f + __expf(-x)); }
#define LDS_WAIT() asm volatile("s_waitcnt lgkmcnt(0)" ::: "memory")
__device__ __forceinline__ int crow(int i, int h) { return (i & 3) + 8 * (i >> 2) + 4 * h; }
__device__ __forceinline__ bf16x8 pack16(const f32x16& x, const int s) {
    u32x4 p; p.x = pk2(x[8 * s], x[8 * s + 1]); p.y = pk2(x[8 * s + 2], x[8 * s + 3]); p.z = pk2(x[8 * s + 4], x[8 * s + 5]); p.w = pk2(x[8 * s + 6], x[8 * s + 7]);
    return __builtin_bit_cast(bf16x8, p);
}
#define MFMA32(a, b, c) __builtin_amdgcn_mfma_f32_32x32x16_bf16((a), (b), (c), 0, 0, 0)
__device__ __forceinline__ bf16x8 ldg16(const bf16_t* p) { return *(const bf16x8*)p; }
__device__ __forceinline__ void lds_add(LAS float* p, float v) { (void)__hip_atomic_fetch_add(p, v, __ATOMIC_RELAXED, __HIP_MEMORY_SCOPE_WORKGROUP); }
__device__ __forceinline__ void lds_add_i(LAS int* p, int v) { (void)__hip_atomic_fetch_add(p, v, __ATOMIC_RELAXED, __HIP_MEMORY_SCOPE_WORKGROUP); }
constexpr float OFIX = 262144.0f, OFIX_INV = 1.0f / 262144.0f;

namespace pg8 {
constexpr int BM = 256, BK = 64, HALF = 128, HTB = HALF * BK * 2, STAGE_BYTES = 8 * HTB, NXCD = 8, WGM = 8;
__host__ __device__ __forceinline__ int lds_byte(int r, int c) { const int st = (r >> 4) * 2 + (c >> 5), rr = r & 15, cc = c & 31, ob = rr * 64 + cc * 2; return st * 1024 + (ob ^ (((ob >> 9) & 1) << 5)); }
__host__ __device__ __forceinline__ void stage_rc(int b, int& R, int& C) { const int st = b / 1024, sb = b % 1024, swz = sb ^ (((sb >> 9) & 1) << 5); R = (st >> 1) * 16 + swz / 64; C = (st & 1) * 32 + (swz % 64) / 2; }
__host__ __device__ __forceinline__ int perm32(int rho) { const int n = rho >> 4, i = rho & 15; return 8 * (i >> 2) + 4 * n + (i & 3); }
struct Unit { int pm, pn; };
struct Gemm { const bf16_t* A; const bf16_t* Bt; int M, N, K; };
struct StaticOrder {
    int nM, nN, nwg, G, c;
    __device__ void init(int M, int N, int G_, int c_) { nM = M / BM; nN = N / BM; nwg = nM * nN; G = G_; c = c_; }
    __device__ bool next(int i, Unit& u) const {
        const long L = (long)i * G + c; if (L >= nwg) return false;
        int wgid = (int)L; { const int q = nwg / NXCD, r = nwg % NXCD, xcd = wgid % NXCD, off = wgid / NXCD; wgid = (xcd < r ? xcd * (q + 1) : r * (q + 1) + (xcd - r) * q) + off; }
        const int nig = WGM * nN, gid = wgid / nig, fm = gid * WGM, gsz = (nM - fm) < WGM ? (nM - fm) : WGM;
        u.pm = fm + ((wgid % nig) % gsz); u.pn = (wgid % nig) / gsz; return true;
    }
};
template <class Epi>
__device__ __forceinline__ void gemm_phase(LAS unsigned char* lds, const Gemm g, const StaticOrder& S, const Epi& E) {
    const int tid = threadIdx.x, wid = __builtin_amdgcn_readfirstlane(tid >> 6), lane = tid & 63, wr = wid >> 2, wc = wid & 3, fr = lane & 15, fq = lane >> 4;
    const int K = g.K, nt = K / BK;
    unsigned voffA[2], voffB[2];
#pragma unroll
    for (int i = 0; i < 2; ++i) { int R, C; stage_rc(tid * 16 + i * 8192, R, C); const int Rb = Epi::PERM ? ((R & ~31) + perm32(R & 31)) : R;
        voffA[i] = (unsigned)(R * K + C) * 2u; voffB[i] = (unsigned)(Rb * K + C) * 2u; }
    const size_t kstep = (size_t)(BK * 2);
    const size_t hstep = (size_t)HALF * K * 2;
    const size_t tstep = 2 * hstep;
    const unsigned ldsw = (unsigned)wid * 1024u;
    const int aoff = lds_byte(wr * 64 + fr, fq * 8), boff = lds_byte(wc * 32 + fr, fq * 8);
#define PG8_SA(b, h) (((b) * 2 + (h)) * HTB)
#define PG8_SB(b, h) ((4 + (b) * 2 + (h)) * HTB)
#define PG8_STAGE(bufoff, gbase, voff) do { _Pragma("unroll") for (int _i = 0; _i < 2; ++_i) \
        __builtin_amdgcn_global_load_lds((const unsigned*)((const char*)(gbase) + (voff)[_i]), (LAS unsigned*)(lds + (bufoff) + ldsw + _i * 8192), 16, 0, 0); } while (0)
#define PG8_LDA(dst, b, h) do { _Pragma("unroll") for (int m = 0; m < 4; ++m) _Pragma("unroll") for (int k = 0; k < 2; ++k) dst[m][k] = *(const LAS bf16x8*)(lds + PG8_SA(b, h) + aoff + m * 2048 + k * 1024); } while (0)
#define PG8_LDB(dst, b, h) do { _Pragma("unroll") for (int n = 0; n < 2; ++n) _Pragma("unroll") for (int k = 0; k < 2; ++k) dst[n][k] = *(const LAS bf16x8*)(lds + PG8_SB(b, h) + boff + n * 2048 + k * 1024); } while (0)
#define PG8_MMA(ai, bj, At, Bt) do { __builtin_amdgcn_s_setprio(1); _Pragma("unroll") for (int m = 0; m < 4; ++m) _Pragma("unroll") for (int n = 0; n < 2; ++n) _Pragma("unroll") for (int k = 0; k < 2; ++k) \
        acc[ai][bj][m][n] = __builtin_amdgcn_mfma_f32_16x16x32_bf16(Bt[n][k], At[m][k], acc[ai][bj][m][n], 0, 0, 0); __builtin_amdgcn_s_setprio(0); } while (0)
#define PG8_WAIT_V(n) asm volatile("s_waitcnt vmcnt(" #n ")" ::: "memory")
#define PG8_WAIT_L(n) asm volatile("s_waitcnt lgkmcnt(" #n ")" ::: "memory")
#define PG8_BAR __builtin_amdgcn_s_barrier()
#define PG8_SCHED __builtin_amdgcn_sched_barrier(0)
    Unit cur, nxt; int ui = 0;
    if (!S.next(0, cur)) return;
    f32x4 acc[2][2][4][2];
#pragma unroll
    for (int a = 0; a < 2; ++a)
#pragma unroll
        for (int b = 0; b < 2; ++b)
#pragma unroll
            for (int m = 0; m < 4; ++m)
#pragma unroll
                for (int n = 0; n < 2; ++n) acc[a][b][m][n] = (f32x4){0.f, 0.f, 0.f, 0.f};
    bf16x8 At[4][2], B0[2][2], B1[2][2];
    const char* cA = (const char*)g.A + (size_t)cur.pm * tstep; const char* cB = (const char*)g.Bt + (size_t)cur.pn * tstep;
    PG8_STAGE(PG8_SB(0, 0), cB, voffB); PG8_STAGE(PG8_SB(0, 1), cB + hstep, voffB); PG8_STAGE(PG8_SA(0, 0), cA, voffA); PG8_STAGE(PG8_SA(0, 1), cA + hstep, voffA);
    if (wr == 1) PG8_BAR;
    PG8_WAIT_V(2); PG8_BAR;
    PG8_STAGE(PG8_SB(1, 0), cB + kstep, voffB); PG8_STAGE(PG8_SA(1, 0), cA + kstep, voffA); PG8_STAGE(PG8_SB(1, 1), cB + hstep + kstep, voffB);
    PG8_WAIT_V(6); PG8_BAR;
    for (;;) {
        const bool has_next = S.next(ui + 1, nxt);
        const char* nA = has_next ? (const char*)g.A + (size_t)nxt.pm * tstep : cA; const char* nB = has_next ? (const char*)g.Bt + (size_t)nxt.pn * tstep : cB;
        for (int t = 0; t < nt; t += 2) {
            const bool last = (t == nt - 2);
            const char* a1 = cA + (size_t)(t + 1) * kstep;
            const char* a2 = last ? nA : cA + (size_t)(t + 2) * kstep; const char* b2 = last ? nB : cB + (size_t)(t + 2) * kstep;
            const char* a3 = a2 + kstep; const char* b3 = b2 + kstep;
            PG8_LDB(B0, 0, 0); PG8_LDB(B1, 0, 1); PG8_SCHED; PG8_LDA(At, 0, 0); PG8_STAGE(PG8_SA(1, 1), a1 + hstep, voffA);
            PG8_WAIT_V(8); PG8_WAIT_L(0); PG8_BAR; PG8_MMA(0, 0, At, B0); PG8_MMA(0, 1, At, B1); PG8_BAR; PG8_SCHED;
            PG8_LDA(At, 0, 1); PG8_STAGE(PG8_SB(0, 0), b2, voffB); PG8_STAGE(PG8_SB(0, 1), b2 + hstep, voffB); PG8_STAGE(PG8_SA(0, 0), a2, voffA);
            PG8_WAIT_V(8); PG8_WAIT_L(0); PG8_BAR; PG8_MMA(1, 0, At, B0); PG8_MMA(1, 1, At, B1); PG8_BAR; PG8_SCHED;
            PG8_LDB(B0, 1, 0); PG8_LDB(B1, 1, 1); PG8_SCHED; PG8_LDA(At, 1, 0); PG8_STAGE(PG8_SA(0, 1), a2 + hstep, voffA);
            PG8_WAIT_V(8); PG8_WAIT_L(0); PG8_BAR; PG8_MMA(0, 0, At, B0); PG8_MMA(0, 1, At, B1); PG8_BAR; PG8_SCHED;
            PG8_LDA(At, 1, 1); PG8_STAGE(PG8_SB(1, 0), b3, voffB); PG8_STAGE(PG8_SB(1, 1), b3 + hstep, voffB); PG8_STAGE(PG8_SA(1, 0), a3, voffA);
            PG8_WAIT_V(8); PG8_WAIT_L(0); PG8_BAR; PG8_MMA(1, 0, At, B0); PG8_MMA(1, 1, At, B1); PG8_BAR; PG8_SCHED;
        }
        if (wr == 0) PG8_BAR;
        E(acc, cur, wr, wc, fr, fq);
        if (!has_next) break;
#pragma unroll
        for (int a = 0; a < 2; ++a)
#pragma unroll
            for (int b = 0; b < 2; ++b)
#pragma unroll
                for (int m = 0; m < 4; ++m)
#pragma unroll
                    for (int n = 0; n < 2; ++n) acc[a][b][m][n] = (f32x4){0.f, 0.f, 0.f, 0.f};
        cur = nxt; cA = nA; cB = nB; ++ui;
        if (wr == 1) PG8_BAR;
    }
    PG8_WAIT_V(0);
    PG8_BAR;
#undef PG8_SA
#undef PG8_SB
#undef PG8_STAGE
#undef PG8_LDA
#undef PG8_LDB
#undef PG8_MMA
#undef PG8_WAIT_V
#undef PG8_WAIT_L
#undef PG8_BAR
#undef PG8_SCHED
}
}
using pg8::Unit;
typedef const f32x4 (&AccRef)[2][2][4][2];

struct EpiRetIn {
    static constexpr bool PERM = true;
    bf16_t *Q, *K, *V, *G; const u64* sumsq; const float* cs;
    __device__ __forceinline__ void operator()(AccRef acc, const Unit& u, int wr, int wc, int fr, int fq) const {
        const int row0 = u.pm * 256 + wr * 64 + fr, pn = u.pn;
        bf16_t* base; int ldc, colt; bool rope = false; float sc = 1.f;
        if (pn < 8) { base = Q; ldc = 2048; colt = pn * 256; rope = true; }
        else if (pn < 16) { base = K; ldc = 2048; colt = (pn - 8) * 256; rope = true; sc = 0.0625f; }
        else if (pn < 32) { base = V; ldc = 4096; colt = (pn - 16) * 256; }
        else { base = G; ldc = 4096; colt = (pn - 32) * 256; }
        const int i0 = wc * 32 + 8 * fq, col0 = colt + i0;
        u64 sq[2][4];
#pragma unroll
        for (int ai = 0; ai < 2; ++ai)
#pragma unroll
            for (int m = 0; m < 4; ++m) sq[ai][m] = sumsq[row0 + ai * 128 + m * 16];
#pragma unroll
        for (int ai = 0; ai < 2; ++ai)
#pragma unroll
            for (int m = 0; m < 4; ++m) {
                const int row = row0 + ai * 128 + m * 16;
                const float rs = ss_rstd(&sq[ai][m], 0) * sc;
                f32x4 a0 = acc[ai][0][m][0] * rs, a1 = acc[ai][0][m][1] * rs, b0 = acc[ai][1][m][0] * rs, b1 = acc[ai][1][m][1] * rs;
                if (rope) {
                    const f32x4* cp = (const f32x4*)(cs + ((size_t)row * 128 + i0) * 2);
                    const f32x4 c01 = cp[0], c23 = cp[1], c45 = cp[2], c67 = cp[3];
                    f32x4 o0, o1, p0, p1;
                    o0[0] = a0[0] * c01[0] - b0[0] * c01[1]; p0[0] = a0[0] * c01[1] + b0[0] * c01[0];
                    o0[1] = a0[1] * c01[2] - b0[1] * c01[3]; p0[1] = a0[1] * c01[3] + b0[1] * c01[2];
                    o0[2] = a0[2] * c23[0] - b0[2] * c23[1]; p0[2] = a0[2] * c23[1] + b0[2] * c23[0];
                    o0[3] = a0[3] * c23[2] - b0[3] * c23[3]; p0[3] = a0[3] * c23[3] + b0[3] * c23[2];
                    o1[0] = a1[0] * c45[0] - b1[0] * c45[1]; p1[0] = a1[0] * c45[1] + b1[0] * c45[0];
                    o1[1] = a1[1] * c45[2] - b1[1] * c45[3]; p1[1] = a1[1] * c45[3] + b1[1] * c45[2];
                    o1[2] = a1[2] * c67[0] - b1[2] * c67[1]; p1[2] = a1[2] * c67[1] + b1[2] * c67[0];
                    o1[3] = a1[3] * c67[2] - b1[3] * c67[3]; p1[3] = a1[3] * c67[3] + b1[3] * c67[2];
                    a0 = o0; a1 = o1; b0 = p0; b1 = p1;
                }
                bf16_t* rowp = base + (size_t)row * ldc + col0;
                u32x4 w; w.x = pk2(a0[0], a0[1]); w.y = pk2(a0[2], a0[3]); w.z = pk2(a1[0], a1[1]); w.w = pk2(a1[2], a1[3]);
                *(u32x4*)rowp = w;
                w.x = pk2(b0[0], b0[1]); w.y = pk2(b0[2], b0[3]); w.z = pk2(b1[0], b1[1]); w.w = pk2(b1[2], b1[3]);
                *(u32x4*)(rowp + 128) = w;
            }
    }
};
struct EpiResid {
    static constexpr bool PERM = true;
    bf16_t* hb; u64* sumsq;
    __device__ __forceinline__ void operator()(AccRef acc, const Unit& u, int wr, int wc, int fr, int fq) const {
        const int row0 = u.pm * 256 + wr * 64 + fr, col0 = u.pn * 256 + wc * 32 + 8 * fq;
#pragma unroll
        for (int ai = 0; ai < 2; ++ai) {
            u32x4 pre[4][2];
#pragma unroll
            for (int m = 0; m < 4; ++m)
#pragma unroll
                for (int bj = 0; bj < 2; ++bj) pre[m][bj] = *(const u32x4*)(hb + (size_t)(row0 + ai * 128 + m * 16) * DM + col0 + bj * 128);
#pragma unroll
            for (int m = 0; m < 4; ++m) {
                const int row = row0 + ai * 128 + m * 16; const size_t off = (size_t)row * DM + col0; float ss = 0.f;
#pragma unroll
                for (int bj = 0; bj < 2; ++bj) {
                    float o[8]; unpack8(pre[m][bj], o);
#pragma unroll
                    for (int j = 0; j < 4; ++j) { o[j] += acc[ai][bj][m][0][j]; o[4 + j] += acc[ai][bj][m][1][j]; }
#pragma unroll
                    for (int j = 0; j < 8; ++j) ss += o[j] * o[j];
                    *(u32x4*)(hb + off + bj * 128) = pack8f(o);
                }
                ss += __shfl_xor(ss, 16); ss += __shfl_xor(ss, 32);
                if (sumsq && fq == 0) atomicAdd(sumsq + row, ss_fix(ss));
            }
        }
    }
};
struct EpiSwiGLU {
    static constexpr bool PERM = true;
    bf16_t* O; const u64* sumsq;
    __device__ __forceinline__ void operator()(AccRef acc, const Unit& u, int wr, int wc, int fr, int fq) const {
        const int row0 = u.pm * 256 + wr * 64 + fr, col0 = u.pn * 128 + wc * 32 + 8 * fq;
        u64 sq[2][4];
#pragma unroll
        for (int ai = 0; ai < 2; ++ai)
#pragma unroll
            for (int m = 0; m < 4; ++m) sq[ai][m] = sumsq[row0 + ai * 128 + m * 16];
#pragma unroll
        for (int ai = 0; ai < 2; ++ai)
#pragma unroll
            for (int m = 0; m < 4; ++m) {
                const int row = row0 + ai * 128 + m * 16;
                const float rs = ss_rstd(&sq[ai][m], 0);
                float o[8];
#pragma unroll
                for (int n = 0; n < 2; ++n)
#pragma unroll
                    for (int j = 0; j < 4; ++j) { const float g = acc[ai][0][m][n][j] * rs, up = acc[ai][1][m][n][j] * rs; o[4 * n + j] = silu_f(g) * up; }
                *(u32x4*)(O + (size_t)row * FF + col0) = pack8f(o);
            }
    }
};
struct EpiMlIn {
    static constexpr bool PERM = true;
    bf16_t *XM, *Z; const u64* sumsq;
    __device__ __forceinline__ void operator()(AccRef acc, const Unit& u, int wr, int wc, int fr, int fq) const {
        const int row0 = u.pm * 256 + wr * 64 + fr, pn = u.pn;
        bf16_t* base = pn < 16 ? XM : Z; const int col0 = (pn & 15) * 256 + wc * 32 + 8 * fq;
        u64 sq[2][4];
#pragma unroll
        for (int ai = 0; ai < 2; ++ai)
#pragma unroll
            for (int m = 0; m < 4; ++m) sq[ai][m] = sumsq[row0 + ai * 128 + m * 16];
#pragma unroll
        for (int ai = 0; ai < 2; ++ai)
#pragma unroll
            for (int m = 0; m < 4; ++m) {
                const int row = row0 + ai * 128 + m * 16;
                const float rs = ss_rstd(&sq[ai][m], 0);
                bf16_t* rowp = base + (size_t)row * 4096 + col0;
#pragma unroll
                for (int bj = 0; bj < 2; ++bj) {
                    const f32x4 v0 = acc[ai][bj][m][0] * rs, v1 = acc[ai][bj][m][1] * rs;
                    u32x4 w; w.x = pk2(v0[0], v0[1]); w.y = pk2(v0[2], v0[3]); w.z = pk2(v1[0], v1[1]); w.w = pk2(v1[2], v1[3]);
                    *(u32x4*)(rowp + bj * 128) = w;
                }
            }
    }
};

__device__ __forceinline__ void convert_weight(const float* W, int K, int N, bf16_t* WT, const float* g, int mode, LAS float* scr, int gw, int ngw, int lane) {
    const int nblk = N / 32, nitems = (K / 64) * nblk;
    for (int it = gw; it < nitems; it += ngw) {
        const int kb = it / nblk, nb = it % nblk, k0 = 64 * kb, n0 = 32 * nb;
        const int orow0 = mode == 0 ? n0 : (256 * (n0 >> 7) + (n0 & 127) + (mode == 2 ? 128 : 0));
        {
            f32x4 wv4[8];
#pragma unroll
            for (int i = 0; i < 8; ++i) wv4[i] = *(const f32x4*)(W + (size_t)(k0 + 8 * i + (lane >> 3)) * N + n0 + 4 * (lane & 7));
#pragma unroll
            for (int i = 0; i < 8; ++i) { const int kk = 8 * i + (lane >> 3); const float gs = g ? g[k0 + kk] : 1.0f; LAS float* d = scr + kk * 33 + 4 * (lane & 7);
                d[0] = wv4[i][0] * gs; d[1] = wv4[i][1] * gs; d[2] = wv4[i][2] * gs; d[3] = wv4[i][3] * gs; }
        }
        LDS_WAIT(); asm volatile("" ::: "memory");
        const int c = lane & 7;
#pragma unroll
        for (int j = 0; j < 4; ++j) { const int n = (lane >> 3) + 8 * j; const LAS float* s = scr + (8 * c) * 33 + n;
            u32x4 o; o.x = pk2(s[0 * 33], s[1 * 33]); o.y = pk2(s[2 * 33], s[3 * 33]); o.z = pk2(s[4 * 33], s[5 * 33]); o.w = pk2(s[6 * 33], s[7 * 33]);
            *(u32x4*)(WT + (size_t)(orow0 + n) * K + k0 + 8 * c) = o; }
        LDS_WAIT(); asm volatile("" ::: "memory");
    }
}

template <int NT, bool ML>
__device__ __forceinline__ void phase_scores(const bf16_t* XQ, const bf16_t* XK, int ldx, const bf16_t* IDT, const u32x2* WQC, const u32x2* WKC, int H, bf16_t* Pout,
                                             const float* GA, const float* GPM, const float* GB, const float* BLAST, const float* PML, float* DENA, float* EMT, float* INTER, float* INTER2, float* CW, float* DEC, float* KW, LAS unsigned char* lds) {
    const int tid = threadIdx.x, wave = __builtin_amdgcn_readfirstlane(tid >> 6), lane = tid & 63, r = lane & 31, hh = lane >> 5;
    LAS unsigned char* buf0 = lds; LAS unsigned char* buf1 = lds + 65536;
    LAS float* l_bl = (LAS float*)(lds + 131072);
    LAS float* l_pl = l_bl + 128;
    LAS float* l_pm = l_pl + 128;
    LAS float* l_rs = l_pm + 128;
    LAS float* l_mp = l_rs + 128;
    LAS float* l_cw = l_mp + 4;
    const int tt = wave >> 1, par = wave & 1;
    const int st0 = par, st1 = par + 2;
    const bool v0 = ML ? st0 <= tt : st0 == tt, v1 = ML ? st1 <= tt : st1 == tt;
    const int bdsel = (hh == ((r >> 3) & 1)) ? ((r >> 4) * 2 + ((r >> 2) & 1)) : -1;
#define BDFRAG(v, ks) __builtin_bit_cast(bf16x8, (u32x4){bdsel == 2 * (ks) ? (v).x : 0u, bdsel == 2 * (ks) ? (v).y : 0u, bdsel == 2 * (ks) + 1 ? (v).x : 0u, bdsel == 2 * (ks) + 1 ? (v).y : 0u})
#define P_ISSUE(bufp, gp) do { _Pragma("unroll") for (int j_ = 0; j_ < 8; ++j_) \
        __builtin_amdgcn_global_load_lds((const unsigned*)((gp) + (size_t)j_ * 16 * ldx), (LAS unsigned*)((bufp) + j_ * 8192 + wave * 1024), 16, 0, 0); } while (0)
#define P_FRAG(bufp, tile, c) (*(const LAS bf16x8*)((bufp) + (32 * (tile) + r) * 512 + ((((c)) ^ (r & 15)) * 16)))
    const int dsl = (tid & 31) ^ ((tid >> 5) & 15);
    const bf16x8 iw0 = ML ? (bf16x8){0, 0, 0, 0, 0, 0, 0, 0} : ldg16(IDT + r * 32 + 8 * hh), iw1 = ML ? (bf16x8){0, 0, 0, 0, 0, 0, 0, 0} : ldg16(IDT + r * 32 + 8 * hh + 16);
    constexpr int NSTEP = ML ? NT / 8 : 1;
    for (int unit = blockIdx.x; unit < NCB * H; unit += gridDim.x) {
        const int cb = unit / H, h = unit % H, row0 = cb * 128, nprev = cb & 127;
        const bf16_t* xqg = XQ + (size_t)(row0 + (tid >> 5)) * ldx + h * (32 * NT) + dsl * 8;
        const bf16_t* xkg = XK + (size_t)(row0 + (tid >> 5)) * ldx + h * (32 * NT) + dsl * 8;
        P_ISSUE(buf0, xqg); if (!ML) P_ISSUE(buf1, xkg);
        float m_prev = 0.f;
        if (ML) {
            if (tid < 128) { l_rs[tid] = 0.f; l_pm[tid] = GPM[(size_t)(row0 + tid) * 4 + h];
                if (tid < nprev) { l_bl[tid] = BLAST[(cb - nprev + tid) * 4 + h]; l_pl[tid] = PML[(cb - nprev + tid) * 4 + h]; } }
            __syncthreads();
            if (tid == 0) { float m = 0.f; for (int c = 0; c < nprev; ++c) m = l_bl[c] + fmaxf(m, l_pl[c]); l_mp[0] = m; }
            __syncthreads();
            m_prev = l_mp[0];
            const float mlast = fmaxf(PML[cb * 4 + h], m_prev);
            if (tid < 128) { const size_t o = (size_t)(row0 + tid) * 4 + h; const float cwv = __expf(GA[o] - mlast); l_cw[tid] = cwv; CW[o] = cwv; const float Mt_ = fmaxf(l_pm[tid], m_prev); INTER[o] = __expf(m_prev - Mt_); INTER2[o] = __expf(mlast - Mt_); }
            if (tid == 0) DEC[cb * 4 + h] = __expf(m_prev - mlast);
        }
        f32x16 Z0, Z1, z;
#pragma unroll
        for (int i = 0; i < 16; ++i) { Z0[i] = 0.f; Z1[i] = 0.f; z[i] = 0.f; }
#pragma unroll 1
        for (int step = 0; step < NSTEP; ++step) {
            if (ML && step + 1 < NSTEP) { P_ISSUE(((step + 1) & 1) ? buf1 : buf0, xqg + (step + 1) * 256); asm volatile("s_waitcnt vmcnt(8)" ::: "memory"); }
            else asm volatile("s_waitcnt vmcnt(0)" ::: "memory");
            __syncthreads();
            LAS unsigned char* qb = ML ? ((step & 1) ? buf1 : buf0) : buf0; LAS unsigned char* kb = ML ? qb : buf1;
#pragma unroll 2
            for (int d = 0; d < 8; ++d) {
                bf16x8 wq0, wq1, wk0, wk1;
                if (ML) { const u32x2 qv = WQC[(size_t)(h * NT + step * 8 + d) * 32 + r], kv = WKC[(size_t)(h * NT + step * 8 + d) * 32 + r];
                    wq0 = BDFRAG(qv, 0); wq1 = BDFRAG(qv, 1); wk0 = BDFRAG(kv, 0); wk1 = BDFRAG(kv, 1); }
                else { wq0 = wk0 = iw0; wq1 = wk1 = iw1; }
                f32x16 qT = MFMA32(wq0, P_FRAG(qb, tt, 4 * d + hh), z); qT = MFMA32(wq1, P_FRAG(qb, tt, 4 * d + 2 + hh), qT);
                const bf16x8 qa0 = pack16(qT, 0), qa1 = pack16(qT, 1);
                if (v0) { f32x16 kT = MFMA32(wk0, P_FRAG(kb, st0, 4 * d + hh), z); kT = MFMA32(wk1, P_FRAG(kb, st0, 4 * d + 2 + hh), kT); Z0 = MFMA32(qa0, pack16(kT, 0), Z0); Z0 = MFMA32(qa1, pack16(kT, 1), Z0); }
                if (v1) { f32x16 kT = MFMA32(wk0, P_FRAG(kb, st1, 4 * d + hh), z); kT = MFMA32(wk1, P_FRAG(kb, st1, 4 * d + 2 + hh), kT); Z1 = MFMA32(qa0, pack16(kT, 0), Z1); Z1 = MFMA32(qa1, pack16(kT, 1), Z1); }
            }
            if (ML) {
                const int dkt = step * 8 + wave;
                const u32x2 kv = WKC[(size_t)(h * NT + dkt) * 32 + r];
                const bf16x8 wk0 = BDFRAG(kv, 0), wk1 = BDFRAG(kv, 1);
                bf16x8 ones;
#pragma unroll
                for (int j = 0; j < 8; ++j) ones[j] = (r == 0) ? (short)0x3f80 : (short)0;
                f32x16 Zk = z;
#pragma unroll
                for (int st = 0; st < 4; ++st) {
                    f32x16 kT = MFMA32(P_FRAG(kb, st, 4 * wave + hh), wk0, z); kT = MFMA32(P_FRAG(kb, st, 4 * wave + 2 + hh), wk1, kT);
#pragma unroll
                    for (int g4 = 0; g4 < 4; ++g4) { const f32x4 c4 = *(const LAS f32x4*)(l_cw + 32 * st + 8 * g4 + 4 * hh);
                        kT[4 * g4] *= c4[0]; kT[4 * g4 + 1] *= c4[1]; kT[4 * g4 + 2] *= c4[2]; kT[4 * g4 + 3] *= c4[3]; }
                    Zk = MFMA32(pack16(kT, 0), ones, Zk); Zk = MFMA32(pack16(kT, 1), ones, Zk);
                }
                if (r == 0) {
#pragma unroll
                    for (int i = 0; i < 16; ++i) KW[(size_t)(cb * 4 + h) * 1024 + 32 * dkt + crow(i, hh)] = Zk[i];
                }
            }
            __syncthreads();
        }
        float rsum[16];
#pragma unroll
        for (int i = 0; i < 16; ++i) rsum[i] = 0.f;
        const float l2g = ML ? 0.f : (float)(log1p(-exp2((double)(-5 - h))) * 1.4426950408889634);
#pragma unroll
        for (int k = 0; k < 2; ++k) {
            const bool vv = k ? v1 : v0; const int st = k ? st1 : st0;
            if (vv) {
                const int s = 32 * st + r;
                const float a_s = ML ? GA[(size_t)(row0 + s) * 4 + h] : 0.f;
#pragma unroll
                for (int i = 0; i < 16; ++i) {
                    const int t = 32 * tt + crow(i, hh);
                    float f;
                    if (ML) { const float Mt = fmaxf(l_pm[t], m_prev); f = __expf(a_s - Mt); } else f = exp2f((float)(t - s) * l2g);
                    const float raw = (t >= s) ? (k ? Z1[i] : Z0[i]) : 0.f;
                    rsum[i] += raw * f;
                    if (st == tt) Pout[((size_t)(row0 + t) * H + h) * 128 + s] = (bf16_t)(pk2(raw, 0.f) & 0xffffu);
                }
            }
        }
        if (ML) {
#pragma unroll
            for (int i = 0; i < 16; ++i) { float v = rsum[i]; v += __shfl_xor(v, 1); v += __shfl_xor(v, 2); v += __shfl_xor(v, 4); v += __shfl_xor(v, 8); v += __shfl_xor(v, 16);
                if (r == 0) lds_add(&l_rs[32 * tt + crow(i, hh)], v); }
            __syncthreads();
            if (tid < 128) { const size_t o = (size_t)(row0 + tid) * 4 + h; DENA[o] = l_rs[tid]; EMT[o] = __expf(-(GB[o] + fmaxf(l_pm[tid], m_prev))); }
            __syncthreads();
        }
    }
#undef BDFRAG
#undef P_ISSUE
#undef P_FRAG
}

template <int NP, bool ML>
__device__ __forceinline__ void phase_scan(const bf16_t* XQ, const bf16_t* XK, int ldx, const bf16_t* WQ, const bf16_t* WK, int H, int dv, bf16_t* VO, const bf16_t* P,
                                           const float* WV, const float* INTER, const float* INTER2, const float* CW, const float* DEC, LAS unsigned char* lds, bool do_store = true) {
    constexpr int NT = 8 * NP, VP = 136;
    constexpr int NST = 3;
    const int tid = threadIdx.x, wave = __builtin_amdgcn_readfirstlane(tid >> 6), lane = tid & 63, r = lane & 31, hh = lane >> 5;
    LAS bf16_t* l_vw = (LAS bf16_t*)lds;
    LAS int* l_os = (LAS int*)(lds + 32 * VP * 2);
    LAS float* l_wv = (LAS float*)(l_os + 128 * 33);
    constexpr int SS = ML ? 2048 : 4096;
    constexpr int NU = 2;
    LAS unsigned char* l_ring = (LAS unsigned char*)(l_wv + 128) + wave * (ML ? NU * 4096 : NST * SS);
    LAS unsigned char* l_pbr = (LAS unsigned char*)(l_wv + 128) + 8 * (ML ? NU * 4096 : NST * SS) + wave * 2560;
    const int nbh = 2 * H, per_xcd = nbh / 8;
    const int bdsel = (hh == ((r >> 3) & 1)) ? ((r >> 4) * 2 + ((r >> 2) & 1)) : -1;
    for (int unit = blockIdx.x; unit < 256; unit += gridDim.x) {
        const int xcd = unit & 7, vq = unit >> 3, bh = xcd * per_xcd + vq % per_xcd, slice = vq / per_xcd;
        const int b = bh / H, h = bh % H, vcol = h * dv + slice * 32, qcol = h * (32 * NT);
        for (int i = tid; i < 128 * 33; i += 512) l_os[i] = 0;
        if (ML && tid < 128) l_wv[tid] = WV[(size_t)(vcol / 4) * 16 + tid];
        f32x16 S[NP];
#pragma unroll
        for (int p = 0; p < NP; ++p) {
#pragma unroll
            for (int i = 0; i < 16; ++i) S[p][i] = 0.f; }
        const int vs = tid >> 2, vc8 = tid & 3;
        const float l2g = ML ? 0.f : (float)(log1p(-exp2((double)(-5 - h))) * 1.4426950408889634);
        const size_t brow0 = (size_t)b * 16384;
        bf16_t* vptr = VO + (brow0 + vs) * 4096 + vcol + 8 * vc8;
        u32x4 vraw = *(const u32x4*)vptr;
        const bf16_t* xq_b = XQ + (brow0 + r) * ldx + qcol + 32 * (wave * NP) + 8 * hh;
        const bf16_t* xk_b = XK + (brow0 + r) * ldx + qcol + 32 * (wave * NP) + 8 * hh;
        const bf16_t* xring_b = XQ + brow0 * ldx + qcol + 32 * (wave * NP);
        const bf16_t* xkring_b = XK + brow0 * ldx + qcol + 32 * (wave * NP);
        const unsigned rgo0 = (unsigned)((lane >> 2) * ldx + (((lane & 3) ^ ((lane >> 4) & 3)) * 8));
        const int rro0 = (4 * r + ((0 + hh) ^ ((r >> 2) & 3))) * 16;
        const unsigned rgoU = (unsigned)((lane >> 3) * ldx + (((lane & 7) ^ ((lane >> 3) & 7)) * 8));
        bf16x8 iw0, iw1; u32x2 qv[NP], kv[NP];
        if (ML) {
#pragma unroll
            for (int p = 0; p < NP; ++p) { const size_t to = (size_t)(h * NT + wave * NP + p) * 1024 + r * 32 + 4 * (r >> 2);
                qv[p] = *(const u32x2*)(WQ + to); kv[p] = *(const u32x2*)(WK + to); }
            iw0 = iw1 = (bf16x8){0, 0, 0, 0, 0, 0, 0, 0};
        } else { iw0 = ldg16(WQ + r * 32 + 8 * hh); iw1 = ldg16(WQ + r * 32 + 8 * hh + 16);
#pragma unroll
            for (int p = 0; p < NP; ++p) { qv[p] = (u32x2){0u, 0u}; kv[p] = (u32x2){0u, 0u}; } }
#define BDFRAG(v, ks) __builtin_bit_cast(bf16x8, (u32x4){bdsel == 2 * (ks) ? (v).x : 0u, bdsel == 2 * (ks) ? (v).y : 0u, bdsel == 2 * (ks) + 1 ? (v).x : 0u, bdsel == 2 * (ks) + 1 ? (v).y : 0u})
#define XOFF(n_, tt_, p_) (((size_t)(n_) * 128 + 32 * (tt_)) * ldx + 32 * (p_))
#define RING_ISSUE(slot_, off_) do { const bf16_t* g_ = xring_b + (off_); \
        __builtin_amdgcn_global_load_lds((const unsigned*)(g_ + rgo0), (LAS unsigned*)(l_ring + (slot_) * SS), 16, 0, 0); \
        __builtin_amdgcn_global_load_lds((const unsigned*)((g_ + 16 * ldx) + rgo0), (LAS unsigned*)(l_ring + (slot_) * SS + 1024), 16, 0, 0); \
        if (!ML) { const bf16_t* k_ = xkring_b + (off_); \
        __builtin_amdgcn_global_load_lds((const unsigned*)(k_ + rgo0), (LAS unsigned*)(l_ring + (slot_) * SS + 2048), 16, 0, 0); \
        __builtin_amdgcn_global_load_lds((const unsigned*)((k_ + 16 * ldx) + rgo0), (LAS unsigned*)(l_ring + (slot_) * SS + 3072), 16, 0, 0); } } while (0)
#define TILE_ISSUE(par_, rr_, t_) do { \
        if ((wave >> 1) == (t_)) __builtin_amdgcn_global_load_lds((const unsigned*)(P + (((rr_) + r) * H + h) * 128 + 32 * (t_) + 16 * (wave & 1) + 8 * hh), (LAS unsigned*)(l_pbr + (par_) * 1280), 16, 0, 0);     \
        __builtin_amdgcn_global_load_lds((const unsigned*)(INTER2 + ((rr_) + r) * 4 + h), (LAS unsigned*)(l_pbr + (par_) * 1280 + 1024), 4, 0, 0); } while (0)
#define UNIT_ISSUE(us_, off_) do { const bf16_t* g_ = xring_b + (off_); _Pragma("unroll") for (int i_ = 0; i_ < 4; ++i_) \
        __builtin_amdgcn_global_load_lds((const unsigned*)((g_ + (size_t)i_ * 8 * ldx) + rgoU), (LAS unsigned*)(l_ring + (us_) * 4096 + i_ * 1024), 16, 0, 0); } while (0)
#define SCAN_STEP(p, tt, Q0, Q1, K0, K1) do { \
        const bf16x8 wq0_ = ML ? BDFRAG(qv[p], 0) : iw0, wq1_ = ML ? BDFRAG(qv[p], 1) : iw1, wk0_ = ML ? BDFRAG(kv[p], 0) : iw0, wk1_ = ML ? BDFRAG(kv[p], 1) : iw1; \
        f32x16 qT = MFMA32(wq0_, Q0, z); qT = MFMA32(wq1_, Q1, qT); \
        { const bf16x8 sa0 = pack16(S[p], 0), sa1 = pack16(S[p], 1);     \
          Oacc = MFMA32(sa0, pack16(qT, 0), Oacc); Oacc = MFMA32(sa1, pack16(qT, 1), Oacc); } \
        if (ML) __builtin_amdgcn_sched_barrier(0);     \
        f32x16 kT = MFMA32(K0, wk0_, z); kT = MFMA32(K1, wk1_, kT); \
        const LAS bf16_t* vwp = l_vw + r * VP + 32 * (tt) + 4 * hh; \
        const s16x4 w00 = *(const LAS s16x4*)(vwp), w01 = *(const LAS s16x4*)(vwp + 8), w10 = *(const LAS s16x4*)(vwp + 16), w11 = *(const LAS s16x4*)(vwp + 24); \
        const bf16x8 vw0 = __builtin_shufflevector(w00, w01, 0, 1, 2, 3, 4, 5, 6, 7), vw1 = __builtin_shufflevector(w10, w11, 0, 1, 2, 3, 4, 5, 6, 7); \
        S[p] = MFMA32(pack16(kT, 0), vw0, S[p]); S[p] = MFMA32(pack16(kT, 1), vw1, S[p]); } while (0)
#define SCAN_TAIL(tt, PB, RSC2) do { \
        if ((wave >> 1) == (tt)) { const bf16x8 va = *(const LAS bf16x8*)(l_vw + r * VP + 32 * (tt) + 16 * (wave & 1) + 8 * hh); Oacc = MFMA32(va, (PB), Oacc); }     \
        _Pragma("unroll") for (int i = 0; i < 16; ++i) Oacc[i] *= (RSC2); \
        _Pragma("unroll") for (int i = 0; i < 16; ++i) lds_add_i(&l_os[(32 * (tt) + r) * 33 + crow(i, hh)], (int)rintf(Oacc[i] * OFIX)); } while (0)
        bf16x8 pb_n; float rsc2_n;
        if constexpr (ML) { TILE_ISSUE(0, brow0, 0); UNIT_ISSUE(0, XOFF(0, 0, 0)); UNIT_ISSUE(1, XOFF(0, 0, 2)); }
        else {
#pragma unroll
            for (int L = 0; L < NST; ++L) RING_ISSUE(L, XOFF(0, L / NP, L % NP));
        }
        pb_n = ldg16(P + ((brow0 + r) * H + h) * 128 + 16 * (wave & 1) + 8 * hh);
        rsc2_n = ML ? INTER2[(brow0 + r) * 4 + h] : exp2f((float)(r - 127) * l2g);
        float decay_n, colw_n;
        if (ML) { decay_n = DEC[(b * 128) * 4 + h]; colw_n = CW[(brow0 + vs) * 4 + h]; }
        else { decay_n = exp2f(128.f * l2g); colw_n = exp2f((float)(127 - vs) * l2g); }
        int slot = 0, uslot = 0; (void)slot; (void)uslot;
        __syncthreads();
        for (int n = 0; n < 128; ++n) {
            const size_t row0 = brow0 + (size_t)n * 128; const int n1 = n + 1 < 128 ? n + 1 : n;
            const float decay = decay_n, colw = colw_n;
            if (ML) { decay_n = DEC[(b * 128 + n1) * 4 + h]; colw_n = CW[(brow0 + (size_t)n1 * 128 + vs) * 4 + h]; }
            {
                float vin[8], vv[8]; unpack8(vraw, vin);
                if (ML) {
#pragma unroll
                    for (int bl = 0; bl < 2; ++bl)
#pragma unroll
                        for (int o = 0; o < 4; ++o) { const f32x4 w4 = *(const LAS f32x4*)(l_wv + (2 * vc8 + bl) * 16 + 4 * o); vv[4 * bl + o] = w4[0] * vin[4 * bl] + w4[1] * vin[4 * bl + 1] + w4[2] * vin[4 * bl + 2] + w4[3] * vin[4 * bl + 3]; }
                } else {
#pragma unroll
                    for (int e = 0; e < 8; ++e) vv[e] = vin[e];
                }
#pragma unroll
                for (int e = 0; e < 8; e += 2) {
                    const unsigned w = pk2(vv[e] * colw, vv[e + 1] * colw);
                    l_vw[(8 * vc8 + e) * VP + vs] = (bf16_t)(w & 0xffffu); l_vw[(8 * vc8 + e + 1) * VP + vs] = (bf16_t)(w >> 16);
                }
                vraw = *(const u32x4*)(vptr + (size_t)n1 * 128 * 4096);
            }
            __syncthreads();
            f32x16 z;
#pragma unroll
            for (int i = 0; i < 16; ++i) z[i] = 0.f;
#pragma unroll
            for (int p = 0; p < NP; ++p) {
#pragma unroll
                for (int i = 0; i < 16; ++i) S[p][i] *= decay;
            }
            if constexpr (ML) {
#pragma unroll 1
                for (int tt = 0; tt < 4; ++tt) {
                    f32x16 Oacc = z;
#pragma unroll
                    for (int pr = 0; pr < 2; ++pr) {
                        asm volatile("s_waitcnt vmcnt(4)" ::: "memory");
                        const LAS unsigned char* ub = l_ring + uslot * 4096 + r * 128;
                        {
                            const bf16x8 q0 = *(const LAS bf16x8*)(ub + (((0 + hh) ^ (r & 7)) * 16)), q1 = *(const LAS bf16x8*)(ub + (((2 + hh) ^ (r & 7)) * 16));
                            SCAN_STEP(2 * pr, tt, q0, q1, q0, q1);
                            __builtin_amdgcn_sched_barrier(0);
                        }
                        {
                            const bf16x8 q0 = *(const LAS bf16x8*)(ub + (((4 + hh) ^ (r & 7)) * 16)), q1 = *(const LAS bf16x8*)(ub + (((6 + hh) ^ (r & 7)) * 16));
                            asm volatile("s_waitcnt lgkmcnt(0)" ::: "memory");
                            { const int tq = tt + (pr + NU) / 2, t2 = tq & 3, n2 = tq >= 4 ? n1 : n; UNIT_ISSUE(uslot, XOFF(n2, t2, 2 * ((pr + NU) & 1))); }
                            if (pr == 0) { const int t1 = (tt + 1) & 3; TILE_ISSUE(t1 & 1, (tt == 3 ? brow0 + (size_t)n1 * 128 : row0) + 32 * t1, t1); }
                            uslot = uslot + 1 == NU ? 0 : uslot + 1;
                            SCAN_STEP(2 * pr + 1, tt, q0, q1, q0, q1);
                            __builtin_amdgcn_sched_barrier(0);
                        }
                    }
                    {
                        const bf16x8 pb = *(const LAS bf16x8*)(l_pbr + (tt & 1) * 1280 + lane * 16); const float rsc2 = *(const LAS float*)(l_pbr + (tt & 1) * 1280 + 1024 + lane * 4);
                        SCAN_TAIL(tt, pb, rsc2);
                    }
                }
            } else
            {
#pragma unroll 1
                for (int tt = 0; tt < 4; ++tt) {
                    f32x16 Oacc = z;
                    const bf16x8 pb = pb_n; const float rsc2 = rsc2_n;
                    { const int t1 = (tt + 1) & 3; const size_t rr = (tt == 3 ? brow0 + (size_t)n1 * 128 : row0) + 32 * t1 + r;
                      if ((wave >> 1) == t1) pb_n = ldg16(P + (rr * H + h) * 128 + 32 * t1 + 16 * (wave & 1) + 8 * hh);
                      rsc2_n = ML ? INTER2[rr * 4 + h] : exp2f((float)(32 * t1 + r - 127) * l2g); }
#pragma unroll
                    for (int p = 0; p < NP; ++p) {
                        if (ML) asm volatile("s_waitcnt vmcnt(4)" ::: "memory"); else asm volatile("s_waitcnt vmcnt(8)" ::: "memory");
                        const bf16x8 cq0 = *(const LAS bf16x8*)(l_ring + slot * SS + rro0), cq1 = *(const LAS bf16x8*)(l_ring + slot * SS + (rro0 ^ 32));
                        bf16x8 ck0, ck1; if (ML) { ck0 = cq0; ck1 = cq1; } else { ck0 = *(const LAS bf16x8*)(l_ring + slot * SS + 2048 + rro0); ck1 = *(const LAS bf16x8*)(l_ring + slot * SS + 2048 + (rro0 ^ 32)); }
                        asm volatile("s_waitcnt lgkmcnt(0)" ::: "memory");
                        { const int p3 = (p + NST) % NP, tq = tt + (p + NST) / NP; const int t3 = tq & 3, n3 = tq >= 4 ? n1 : n; RING_ISSUE(slot, XOFF(n3, t3, p3)); }
                        slot = slot + 1 == NST ? 0 : slot + 1;
#if defined(PROBE_SKIP) && (PROBE_SKIP & 1)
                        if (do_store) { SCAN_STEP(p, tt, cq0, cq1, ck0, ck1); } else { S[p][0] += (float)cq0[0] + (float)ck1[0]; }
#else
                        SCAN_STEP(p, tt, cq0, cq1, ck0, ck1);
#endif
                        __builtin_amdgcn_sched_barrier(0);
                    }
                    SCAN_TAIL(tt, pb, rsc2);
                }
            }
            __syncthreads();
            {
                float o[8]; LAS int* op = l_os + vs * 33 + 8 * vc8;
#pragma unroll
                for (int e = 0; e < 8; ++e) { o[e] = (float)op[e] * OFIX_INV; op[e] = 0; }
                if (do_store) *(u32x4*)(vptr + (size_t)n * 128 * 4096) = pack8f(o);
            }
        }
        asm volatile("s_waitcnt vmcnt(0)" ::: "memory");
        __syncthreads();
#undef BDFRAG
#undef XOFF
#undef RING_ISSUE
#undef UNIT_ISSUE
#undef TILE_ISSUE
#undef SCAN_STEP
#undef SCAN_TAIL
    }
}


#define XB_TMO      128
#define XB_XCNT(j)  (256  + 64 * (j))
#define XB_XSUB(j)  (1280 + 64 * (j))
#define XB_XGEN(j)  (2304 + 64 * (j))
#define XB_TOP      3328
#define XB_TOPGEN   3392
#define XCD_BAR_WORDS 3456
#define XB_SPIN_CAP (1u << 18)
__device__ __forceinline__ unsigned xb_ld(unsigned* p)              { return __hip_atomic_load(p, __ATOMIC_RELAXED, __HIP_MEMORY_SCOPE_AGENT); }
__device__ __forceinline__ unsigned xb_add(unsigned* p, unsigned v) { return __hip_atomic_fetch_add(p, v, __ATOMIC_RELAXED, __HIP_MEMORY_SCOPE_AGENT); }
__device__ __forceinline__ unsigned xb_xcc_id() { return (unsigned)__builtin_amdgcn_s_getreg((3 << 11) | 20) & 0xFu; }
#define XB_SPIN(cond, bar) do { unsigned _sp = 0; while (cond) { __builtin_amdgcn_s_sleep(1); \
    if ((++_sp & 255u) == 0u) { if (xb_ld(&(bar)[XB_TMO])) break; if (_sp > XB_SPIN_CAP) { atomicAdd(&(bar)[XB_TMO], 1u); break; } } } } while (0)
struct XcdBarrier { unsigned* bar; unsigned x; volatile LAS unsigned* st; };
__device__ __forceinline__ XcdBarrier xcd_barrier_post(unsigned* bar, volatile LAS unsigned* st) {
    XcdBarrier b; b.bar = bar; b.x = xb_xcc_id(); b.st = st;
    if (threadIdx.x == 0) (void)xb_add(&bar[XB_XCNT(b.x)], 1u);
    return b;
}
__device__ __forceinline__ void xcd_barrier_complete(unsigned* bar, unsigned x, unsigned& nloc, unsigned& nx) {
    const unsigned G = gridDim.x * gridDim.y * gridDim.z;
    unsigned sum, cnt, mine, sp = 0u;
    for (;;) {
        sum = 0u; cnt = 0u; mine = 0u;
#pragma unroll
        for (unsigned j = 0; j < 16; ++j) { const unsigned c = xb_ld(&bar[XB_XCNT(j)]); sum += c; cnt += (c > 0u) ? 1u : 0u; mine = (j == x) ? c : mine; }
        if (sum == G) break;
        __builtin_amdgcn_s_sleep(1);
        if ((++sp & 255u) == 0u) { if (xb_ld(&bar[XB_TMO])) break; if (sp > XB_SPIN_CAP) { atomicAdd(&bar[XB_TMO], 1u); break; } }
    }
    nloc = mine > 0u ? mine : 1u; nx = cnt > 0u ? cnt : 1u;
}
__device__ __forceinline__ void xcd_barrier(const XcdBarrier& b) {
    asm volatile("s_waitcnt vmcnt(0)" ::: "memory");
    __syncthreads();
    if (threadIdx.x == 0) {
        unsigned* bar = b.bar;
        __builtin_amdgcn_s_waitcnt(0);
        unsigned nloc = b.st[0], nx = b.st[1];
        if (nloc == 0u) { xcd_barrier_complete(bar, b.x, nloc, nx); b.st[0] = nloc; b.st[1] = nx; }
        const unsigned old = xb_add(&bar[XB_XSUB(b.x)], 1u);
        const unsigned gen = old / nloc;
        if (old + 1u == (gen + 1u) * nloc) {
            __builtin_amdgcn_fence(__ATOMIC_RELEASE, "agent");
            asm volatile("s_waitcnt vmcnt(0)" ::: "memory");
            const unsigned og = xb_add(&bar[XB_TOP], 1u);
            const unsigned tg = og / nx;
            if (og + 1u == (tg + 1u) * nx) xb_add(&bar[XB_TOPGEN], 1u);
            else XB_SPIN(xb_ld(&bar[XB_TOPGEN]) == tg, bar);
            __builtin_amdgcn_fence(__ATOMIC_ACQUIRE, "agent");
            xb_add(&bar[XB_XGEN(b.x)], 1u);
            asm volatile("s_waitcnt vmcnt(0)" ::: "memory");
        } else {
            XB_SPIN(xb_ld(&bar[XB_XGEN(b.x)]) == gen, bar);
            __builtin_amdgcn_fence(__ATOMIC_ACQUIRE, "agent");
            asm volatile("s_waitcnt vmcnt(0)" ::: "memory");
        }
    }
    __syncthreads();
}

constexpr int LDS_BYTES = 163840;
enum { PH_PRO = 0, PH_G1, PH_RP, PH_RS, PH_RF, PH_G2, PH_G3, PH_G4, PH_G5, PH_MC, PH_MP, PH_MS, PH_MF, PH_G6, PH_G7, PH_G8, PH_FIN, PH_N };

__global__ void __launch_bounds__(512) mega(Params p) {
    extern __shared__ __attribute__((aligned(16))) unsigned char shm[];
    LAS unsigned char* lds = (LAS unsigned char*)shm;
    cg::grid_group grid = cg::this_grid();
    const int tid = threadIdx.x, wave = __builtin_amdgcn_readfirstlane(tid >> 6), lane = tid & 63;
    const int G = gridDim.x, gw = blockIdx.x * 8 + wave, ngw = G * 8;
    const size_t gtid = (size_t)blockIdx.x * 512 + tid, gthreads = (size_t)G * 512;
    unsigned char* ws = p.ws;
    u64* sumsq = (u64*)(ws + WS_SUMSQ);
    bf16_t* hb = (bf16_t*)(ws + WS_RA);
    float* out = p.out;
    unsigned char* dob = (unsigned char*)p.out;
    LAS float* scr = (LAS float*)(lds + wave * 16384);
    const int lo = p.ph_lo, hi = p.ph_hi;
#ifdef ONLY_PHASE
#define IN(k) ((k) == ONLY_PHASE && lo <= (k) && (k) < hi)
#else
#define IN(k) (lo <= (k) && (k) < hi)
#endif
#ifndef MK_XCD_BARRIER
#define MK_XCD_BARRIER 1
#endif
    volatile LAS unsigned* bst = (volatile LAS unsigned*)(lds + LDS_BYTES - 64);
    if (tid < 2) bst[tid] = 0u;
    __syncthreads();
    XcdBarrier xbar; xbar.bar = (unsigned*)(ws + WS_BAR); xbar.x = 0; xbar.st = bst;

#define SEAM(k) do { if (IN(k) && IN((k) + 1)) { if (!MK_XCD_BARRIER) grid.sync(); else if ((k) == PH_PRO) { grid.sync(); xbar = xcd_barrier_post((unsigned*)(ws + WS_BAR), bst); } else xcd_barrier(xbar); } } while (0)
#ifndef REP_MASK
#define REP_MASK 0
#endif
    int mf_pass_ = 0; (void)mf_pass_;


    if (IN(PH_PRO)) {
        for (size_t i = gtid; i < (size_t)4 * T; i += gthreads) sumsq[T + i] = 0ull;
        if (blockIdx.x == 0) for (int i = tid; i < 4096; i += 512) ((unsigned*)(ws + WS_BAR))[i] = 0u;
        {
            f32x4 nx[8];
            if (gw < T) { const f32x4* xr = (const f32x4*)(p.in[0] + (size_t)gw * DM) + lane;
#pragma unroll
                for (int j = 0; j < 8; ++j) nx[j] = xr[64 * j]; }
            for (int m = gw; m < T; m += ngw) {
                f32x4 cx[8];
#pragma unroll
                for (int j = 0; j < 8; ++j) cx[j] = nx[j];
                { const int mn = m + ngw < T ? m + ngw : m; const f32x4* xr = (const f32x4*)(p.in[0] + (size_t)mn * DM) + lane;
#pragma unroll
                  for (int j = 0; j < 8; ++j) nx[j] = xr[64 * j]; }
                float s = 0.f;
                unsigned long long* o8 = (unsigned long long*)(hb + (size_t)m * DM) + lane;
#pragma unroll
                for (int j = 0; j < 8; ++j) { const f32x4 v = cx[j]; s += (v[0] * v[0] + v[1] * v[1]) + (v[2] * v[2] + v[3] * v[3]);
                    o8[64 * j] = (unsigned long long)pk2(v[0], v[1]) | ((unsigned long long)pk2(v[2], v[3]) << 32); }
                s = wave_sum(s); if (lane == 0) sumsq[m] = ss_fix(s);
            }
        }
        convert_weight(p.in[4], DM, 12288, (bf16_t*)(dob + DO_WT1), p.in[2], 0, scr, gw, ngw, lane);
        convert_weight(p.in[6], 4096, DM, (bf16_t*)(ws + WS_WT2), nullptr, 0, scr, gw, ngw, lane);
        convert_weight(p.in[18], DM, FF, (bf16_t*)(ws + WS_WT3), p.in[3], 1, scr, gw, ngw, lane);
        convert_weight(p.in[19], DM, FF, (bf16_t*)(ws + WS_WT3), p.in[3], 2, scr, gw, ngw, lane);
        convert_weight(p.in[20], FF, DM, (bf16_t*)(ws + WS_WT4), nullptr, 0, scr, gw, ngw, lane);
        { const int* pos = (const int*)p.in[1]; f32x2* cs = (f32x2*)(dob + DO_CS);
            for (size_t i = gtid; i < (size_t)T * 128; i += gthreads) { const int t = (int)(i >> 7), f = (int)(i & 127);
                const float inv = exp2f(-(float)f * (13.287712379549449f / 128.0f)); const float ang = (float)pos[t] * inv;
                cs[i] = (f32x2){cosf(ang), sinf(ang)}; } }
        { bf16_t* bdq = (bf16_t*)(ws + WS_BDQ); bf16_t* bdk = (bf16_t*)(ws + WS_BDK); bf16_t* idt = (bf16_t*)(ws + WS_IDT);
            for (size_t i = gtid; i < (size_t)128 * 1024; i += gthreads) { const int tile = (int)(i >> 10), d = (int)((i >> 5) & 31), c = (int)(i & 31);
                float q = 0.f, k = 0.f; if ((d >> 2) == (c >> 2)) { const size_t wi = (size_t)(tile * 8 + (d >> 2)) * 16 + (d & 3) * 4 + (c & 3); q = p.in[10][wi]; k = p.in[11][wi] * 0.03125f; }
                bdq[i] = (bf16_t)(pk2(q, 0.f) & 0xffffu); bdk[i] = (bf16_t)(pk2(k, 0.f) & 0xffffu);
                if (i < 1024) idt[i] = (d == c) ? (bf16_t)0x3f80u : (bf16_t)0; }
            u32x2* bqc = (u32x2*)(ws + WS_BDQC); u32x2* bkc = (u32x2*)(ws + WS_BDKC);
            for (size_t i = gtid; i < (size_t)128 * 32; i += gthreads) { const int tile = (int)(i >> 5), rr = (int)(i & 31); const size_t wi = (size_t)(tile * 8 + (rr >> 2)) * 16 + (rr & 3) * 4;
                bqc[i] = (u32x2){pk2(p.in[10][wi], p.in[10][wi + 1]), pk2(p.in[10][wi + 2], p.in[10][wi + 3])};
                bkc[i] = (u32x2){pk2(p.in[11][wi] * 0.03125f, p.in[11][wi + 1] * 0.03125f), pk2(p.in[11][wi + 2] * 0.03125f, p.in[11][wi + 3] * 0.03125f)}; } }
        { bf16_t* wch = (bf16_t*)(ws + WS_WGC); bf16_t* wcl = wch + 32768; bf16_t* wmh = (bf16_t*)(ws + WS_WGM); bf16_t* wml = wmh + 32768; const float* wg = p.in[13];
            for (size_t i = gtid; i < (size_t)4096 * 8; i += gthreads) { const int c = (int)(i >> 3), g = (int)(i & 7), nb = c >> 2, ii = c & 3; float a = 0.f, bm = 0.f;
#pragma unroll
                for (int o = 0; o < 4; ++o) { const size_t wi = (size_t)nb * 16 + o * 4 + ii;
                    a += p.in[10][wi] * wg[(size_t)(4 * nb + o) * 8 + g] + p.in[11][wi] * wg[(size_t)(4096 + 4 * nb + o) * 8 + g];
                    bm += p.in[12][wi] * wg[(size_t)(8192 + 4 * nb + o) * 8 + g]; }
                const unsigned ah = pk2(a, 0.f) & 0xffffu, mh = pk2(bm, 0.f) & 0xffffu;
                wch[g * 4096 + c] = (bf16_t)ah; wcl[g * 4096 + c] = (bf16_t)(pk2(a - bflo(ah), 0.f) & 0xffffu);
                wmh[g * 4096 + c] = (bf16_t)mh; wml[g * 4096 + c] = (bf16_t)(pk2(bm - bflo(mh), 0.f) & 0xffffu); } }
    }
#if (REP_MASK >> 0) & 1
    grid.sync();
    if (IN(PH_PRO)) {
        for (size_t i = gtid; i < (size_t)4 * T; i += gthreads) sumsq[T + i] = 0ull;
        if (blockIdx.x == 0) for (int i = tid; i < 4096; i += 512) ((unsigned*)(ws + WS_BAR))[i] = 0u;
        {
            f32x4 nx[8];
            if (gw < T) { const f32x4* xr = (const f32x4*)(p.in[0] + (size_t)gw * DM) + lane;
#pragma unroll
                for (int j = 0; j < 8; ++j) nx[j] = xr[64 * j]; }
            for (int m = gw; m < T; m += ngw) {
                f32x4 cx[8];
#pragma unroll
                for (int j = 0; j < 8; ++j) cx[j] = nx[j];
                { const int mn = m + ngw < T ? m + ngw : m; const f32x4* xr = (const f32x4*)(p.in[0] + (size_t)mn * DM) + lane;
#pragma unroll
                  for (int j = 0; j < 8; ++j) nx[j] = xr[64 * j]; }
                float s = 0.f;
                unsigned long long* o8 = (unsigned long long*)(hb + (size_t)m * DM) + lane;
#pragma unroll
                for (int j = 0; j < 8; ++j) { const f32x4 v = cx[j]; s += (v[0] * v[0] + v[1] * v[1]) + (v[2] * v[2] + v[3] * v[3]);
                    o8[64 * j] = (unsigned long long)pk2(v[0], v[1]) | ((unsigned long long)pk2(v[2], v[3]) << 32); }
                s = wave_sum(s); if (lane == 0) sumsq[m] = ss_fix(s);
            }
        }
        convert_weight(p.in[4], DM, 12288, (bf16_t*)(dob + DO_WT1), p.in[2], 0, scr, gw, ngw, lane);
        convert_weight(p.in[6], 4096, DM, (bf16_t*)(ws + WS_WT2), nullptr, 0, scr, gw, ngw, lane);
        convert_weight(p.in[18], DM, FF, (bf16_t*)(ws + WS_WT3), p.in[3], 1, scr, gw, ngw, lane);
        convert_weight(p.in[19], DM, FF, (bf16_t*)(ws + WS_WT3), p.in[3], 2, scr, gw, ngw, lane);
        convert_weight(p.in[20], FF, DM, (bf16_t*)(ws + WS_WT4), nullptr, 0, scr, gw, ngw, lane);
        { const int* pos = (const int*)p.in[1]; f32x2* cs = (f32x2*)(dob + DO_CS);
            for (size_t i = gtid; i < (size_t)T * 128; i += gthreads) { const int t = (int)(i >> 7), f = (int)(i & 127);
                const float inv = exp2f(-(float)f * (13.287712379549449f / 128.0f)); const float ang = (float)pos[t] * inv;
                cs[i] = (f32x2){cosf(ang), sinf(ang)}; } }
        { bf16_t* bdq = (bf16_t*)(ws + WS_BDQ); bf16_t* bdk = (bf16_t*)(ws + WS_BDK); bf16_t* idt = (bf16_t*)(ws + WS_IDT);
            for (size_t i = gtid; i < (size_t)128 * 1024; i += gthreads) { const int tile = (int)(i >> 10), d = (int)((i >> 5) & 31), c = (int)(i & 31);
                float q = 0.f, k = 0.f; if ((d >> 2) == (c >> 2)) { const size_t wi = (size_t)(tile * 8 + (d >> 2)) * 16 + (d & 3) * 4 + (c & 3); q = p.in[10][wi]; k = p.in[11][wi] * 0.03125f; }
                bdq[i] = (bf16_t)(pk2(q, 0.f) & 0xffffu); bdk[i] = (bf16_t)(pk2(k, 0.f) & 0xffffu);
                if (i < 1024) idt[i] = (d == c) ? (bf16_t)0x3f80u : (bf16_t)0; }
            u32x2* bqc = (u32x2*)(ws + WS_BDQC); u32x2* bkc = (u32x2*)(ws + WS_BDKC);
            for (size_t i = gtid; i < (size_t)128 * 32; i += gthreads) { const int tile = (int)(i >> 5), rr = (int)(i & 31); const size_t wi = (size_t)(tile * 8 + (rr >> 2)) * 16 + (rr & 3) * 4;
                bqc[i] = (u32x2){pk2(p.in[10][wi], p.in[10][wi + 1]), pk2(p.in[10][wi + 2], p.in[10][wi + 3])};
                bkc[i] = (u32x2){pk2(p.in[11][wi] * 0.03125f, p.in[11][wi + 1] * 0.03125f), pk2(p.in[11][wi + 2] * 0.03125f, p.in[11][wi + 3] * 0.03125f)}; } }
        { bf16_t* wch = (bf16_t*)(ws + WS_WGC); bf16_t* wcl = wch + 32768; bf16_t* wmh = (bf16_t*)(ws + WS_WGM); bf16_t* wml = wmh + 32768; const float* wg = p.in[13];
            for (size_t i = gtid; i < (size_t)4096 * 8; i += gthreads) { const int c = (int)(i >> 3), g = (int)(i & 7), nb = c >> 2, ii = c & 3; float a = 0.f, bm = 0.f;
#pragma unroll
                for (int o = 0; o < 4; ++o) { const size_t wi = (size_t)nb * 16 + o * 4 + ii;
                    a += p.in[10][wi] * wg[(size_t)(4 * nb + o) * 8 + g] + p.in[11][wi] * wg[(size_t)(4096 + 4 * nb + o) * 8 + g];
                    bm += p.in[12][wi] * wg[(size_t)(8192 + 4 * nb + o) * 8 + g]; }
                const unsigned ah = pk2(a, 0.f) & 0xffffu, mh = pk2(bm, 0.f) & 0xffffu;
                wch[g * 4096 + c] = (bf16_t)ah; wcl[g * 4096 + c] = (bf16_t)(pk2(a - bflo(ah), 0.f) & 0xffffu);
                wmh[g * 4096 + c] = (bf16_t)mh; wml[g * 4096 + c] = (bf16_t)(pk2(bm - bflo(mh), 0.f) & 0xffffu); } }
    }
#endif
    SEAM(PH_PRO);

    if (IN(PH_G1)) {
        pg8::Gemm g{hb, (const bf16_t*)(dob + DO_WT1), T, 12288, DM}; pg8::StaticOrder S; S.init(T, 12288, G, (int)blockIdx.x);
        EpiRetIn E{(bf16_t*)(ws + WS_Q), (bf16_t*)(ws + WS_K), (bf16_t*)(ws + WS_V), (bf16_t*)(ws + WS_G), sumsq, (const float*)(dob + DO_CS)};
        pg8::gemm_phase(lds, g, S, E);
    }
#if (REP_MASK >> 1) & 1
    grid.sync();
    if (IN(PH_G1)) {
        pg8::Gemm g{hb, (const bf16_t*)(dob + DO_WT1), T, 12288, DM}; pg8::StaticOrder S; S.init(T, 12288, G, (int)blockIdx.x);
        EpiRetIn E{(bf16_t*)(ws + WS_Q), (bf16_t*)(ws + WS_K), (bf16_t*)(ws + WS_V), (bf16_t*)(ws + WS_G), sumsq, (const float*)(dob + DO_CS)};
        pg8::gemm_phase(lds, g, S, E);
    }
#endif
    SEAM(PH_G1);
    if (IN(PH_RP)) {
        const bf16_t* idt = (const bf16_t*)(ws + WS_IDT);
        phase_scores<8, false>((const bf16_t*)(ws + WS_Q), (const bf16_t*)(ws + WS_K), 2048, idt, nullptr, nullptr, 8, (bf16_t*)(dob + DO_P0), nullptr, nullptr, nullptr, nullptr, nullptr, nullptr, nullptr, nullptr, nullptr, nullptr, nullptr, nullptr, lds);
    }
#if (REP_MASK >> 2) & 1
    grid.sync();
    if (IN(PH_RP)) {
        const bf16_t* idt = (const bf16_t*)(ws + WS_IDT);
        phase_scores<8, false>((const bf16_t*)(ws + WS_Q), (const bf16_t*)(ws + WS_K), 2048, idt, nullptr, nullptr, 8, (bf16_t*)(dob + DO_P0), nullptr, nullptr, nullptr, nullptr, nullptr, nullptr, nullptr, nullptr, nullptr, nullptr, nullptr, nullptr, lds);
    }
#endif
    SEAM(PH_RP);
    if (IN(PH_RS)) {
        const bf16_t* idt = (const bf16_t*)(ws + WS_IDT);
        phase_scan<1, false>((const bf16_t*)(ws + WS_Q), (const bf16_t*)(ws + WS_K), 2048, idt, idt, 8, 512, (bf16_t*)(ws + WS_V), (const bf16_t*)(dob + DO_P0), nullptr, nullptr, nullptr, nullptr, nullptr, lds, !((REP_MASK >> 3) & 1));
    }
#if (REP_MASK >> 3) & 1
    grid.sync();
    if (IN(PH_RS)) {
        const bf16_t* idt = (const bf16_t*)(ws + WS_IDT);
        phase_scan<1, false>((const bf16_t*)(ws + WS_Q), (const bf16_t*)(ws + WS_K), 2048, idt, idt, 8, 512, (bf16_t*)(ws + WS_V), (const bf16_t*)(dob + DO_P0), nullptr, nullptr, nullptr, nullptr, nullptr, lds);
    }
#endif
    SEAM(PH_RS);
    if (IN(PH_RF)) {
        const bf16_t* O = (const bf16_t*)(ws + WS_V); const bf16_t* Gt = (const bf16_t*)(ws + WS_G); bf16_t* Y = (bf16_t*)(ws + WS_Y); const float* gn = p.in[5];
        for (int it0 = gw; it0 < T * 8; it0 += 4 * ngw) {
            u32x4 ro[4], rg[4];
#pragma unroll
            for (int u = 0; u < 4; ++u) { const int it = it0 + u * ngw < T * 8 ? it0 + u * ngw : it0; const size_t off = (size_t)(it >> 3) * 4096 + (it & 7) * 512 + lane * 8;
                ro[u] = *(const u32x4*)(O + off); rg[u] = *(const u32x4*)(Gt + off); }
#pragma unroll
            for (int u = 0; u < 4; ++u) {
                const int it = it0 + u * ngw; if (it >= T * 8) break;
                const size_t off = (size_t)(it >> 3) * 4096 + (it & 7) * 512 + lane * 8;
                float o[8], gt[8]; unpack8(ro[u], o); unpack8(rg[u], gt);
                float s = 0.f;
#pragma unroll
                for (int e = 0; e < 8; ++e) s += o[e];
                const float mu = wave_sum(s) * (1.f / 512.f); float q = 0.f;
#pragma unroll
                for (int e = 0; e < 8; ++e) { o[e] -= mu; q += o[e] * o[e]; }
                const float rstd = rsqrtf(wave_sum(q) * (1.f / 512.f) + EPSN);
                const f32x4 g0 = *(const f32x4*)(gn + (it & 7) * 512 + lane * 8), g1 = *(const f32x4*)(gn + (it & 7) * 512 + lane * 8 + 4);
                float y[8];
#pragma unroll
                for (int e = 0; e < 8; ++e) y[e] = o[e] * rstd * (e < 4 ? g0[e & 3] : g1[e & 3]) * silu_f(gt[e]);
                *(u32x4*)(Y + off) = pack8f(y);
            }
        }
    }
#if (REP_MASK >> 4) & 1
    grid.sync();
    if (IN(PH_RF)) {
        const bf16_t* O = (const bf16_t*)(ws + WS_V); const bf16_t* Gt = (const bf16_t*)(ws + WS_G); bf16_t* Y = (bf16_t*)(ws + WS_Y); const float* gn = p.in[5];
        for (int it0 = gw; it0 < T * 8; it0 += 4 * ngw) {
            u32x4 ro[4], rg[4];
#pragma unroll
            for (int u = 0; u < 4; ++u) { const int it = it0 + u * ngw < T * 8 ? it0 + u * ngw : it0; const size_t off = (size_t)(it >> 3) * 4096 + (it & 7) * 512 + lane * 8;
                ro[u] = *(const u32x4*)(O + off); rg[u] = *(const u32x4*)(Gt + off); }
#pragma unroll
            for (int u = 0; u < 4; ++u) {
                const int it = it0 + u * ngw; if (it >= T * 8) break;
                const size_t off = (size_t)(it >> 3) * 4096 + (it & 7) * 512 + lane * 8;
                float o[8], gt[8]; unpack8(ro[u], o); unpack8(rg[u], gt);
                float s = 0.f;
#pragma unroll
                for (int e = 0; e < 8; ++e) s += o[e];
                const float mu = wave_sum(s) * (1.f / 512.f); float q = 0.f;
#pragma unroll
                for (int e = 0; e < 8; ++e) { o[e] -= mu; q += o[e] * o[e]; }
                const float rstd = rsqrtf(wave_sum(q) * (1.f / 512.f) + EPSN);
                const f32x4 g0 = *(const f32x4*)(gn + (it & 7) * 512 + lane * 8), g1 = *(const f32x4*)(gn + (it & 7) * 512 + lane * 8 + 4);
                float y[8];
#pragma unroll
                for (int e = 0; e < 8; ++e) y[e] = o[e] * rstd * (e < 4 ? g0[e & 3] : g1[e & 3]) * silu_f(gt[e]);
                *(u32x4*)(Y + off) = pack8f(y);
            }
        }
    }
#endif
    SEAM(PH_RF);
    if (IN(PH_G2)) {
        convert_weight(p.in[7], DM, 8192, (bf16_t*)(ws + WS_WT5), p.in[2] + DM, 0, scr, gw, ngw, lane);
        __syncthreads();
        pg8::Gemm g{(const bf16_t*)(ws + WS_Y), (const bf16_t*)(ws + WS_WT2), T, DM, 4096}; pg8::StaticOrder S; S.init(T, DM, G, (int)blockIdx.x);
        EpiResid E{hb, sumsq + T};
        pg8::gemm_phase(lds, g, S, E);
    }
#if (REP_MASK >> 5) & 1
    grid.sync();
    if (IN(PH_G2)) {
        convert_weight(p.in[7], DM, 8192, (bf16_t*)(ws + WS_WT5), p.in[2] + DM, 0, scr, gw, ngw, lane);
        __syncthreads();
        pg8::Gemm g{(const bf16_t*)(ws + WS_Y), (const bf16_t*)(ws + WS_WT2), T, DM, 4096}; pg8::StaticOrder S; S.init(T, DM, G, (int)blockIdx.x);
        EpiResid E{hb, sumsq + T};
        pg8::gemm_phase(lds, g, S, E);
    }
#endif
    SEAM(PH_G2);
    if (IN(PH_G3)) {
        pg8::Gemm g{hb, (const bf16_t*)(ws + WS_WT3), T, 2 * FF, DM}; pg8::StaticOrder S; S.init(T, 2 * FF, G, (int)blockIdx.x);
        EpiSwiGLU E{(bf16_t*)(ws + WS_ACT0), sumsq + T};
        pg8::gemm_phase(lds, g, S, E);
    }
#if (REP_MASK >> 6) & 1
    grid.sync();
    if (IN(PH_G3)) {
        pg8::Gemm g{hb, (const bf16_t*)(ws + WS_WT3), T, 2 * FF, DM}; pg8::StaticOrder S; S.init(T, 2 * FF, G, (int)blockIdx.x);
        EpiSwiGLU E{(bf16_t*)(ws + WS_ACT0), sumsq + T};
        pg8::gemm_phase(lds, g, S, E);
    }
#endif
    SEAM(PH_G3);
    if (IN(PH_G4)) {
        pg8::Gemm g{(const bf16_t*)(ws + WS_ACT0), (const bf16_t*)(ws + WS_WT4), T, DM, FF}; pg8::StaticOrder S; S.init(T, DM, G, (int)blockIdx.x);
        EpiResid E{hb, sumsq + 2 * T};
        pg8::gemm_phase(lds, g, S, E);
    }
#if (REP_MASK >> 7) & 1
    grid.sync();
    if (IN(PH_G4)) {
        pg8::Gemm g{(const bf16_t*)(ws + WS_ACT0), (const bf16_t*)(ws + WS_WT4), T, DM, FF}; pg8::StaticOrder S; S.init(T, DM, G, (int)blockIdx.x);
        EpiResid E{hb, sumsq + 2 * T};
        pg8::gemm_phase(lds, g, S, E);
    }
#endif
    SEAM(PH_G4);

    if (IN(PH_G5)) {
        convert_weight(p.in[17], 4096, DM, (bf16_t*)(ws + WS_WT6), nullptr, 0, scr, gw, ngw, lane);
        convert_weight(p.in[18] + (size_t)DM * FF, DM, FF, (bf16_t*)(ws + WS_WT7), p.in[3] + DM, 1, scr, gw, ngw, lane);
        convert_weight(p.in[19] + (size_t)DM * FF, DM, FF, (bf16_t*)(ws + WS_WT7), p.in[3] + DM, 2, scr, gw, ngw, lane);
        convert_weight(p.in[20] + (size_t)FF * DM, FF, DM, (bf16_t*)(ws + WS_WT8), nullptr, 0, scr, gw, ngw, lane);
        __syncthreads();
        pg8::Gemm g{hb, (const bf16_t*)(ws + WS_WT5), T, 8192, DM}; pg8::StaticOrder S; S.init(T, 8192, G, (int)blockIdx.x);
        EpiMlIn E{(bf16_t*)(ws + WS_XM), (bf16_t*)(ws + WS_Z), sumsq + 2 * T};
        pg8::gemm_phase(lds, g, S, E);
    }
#if (REP_MASK >> 8) & 1
    grid.sync();
    if (IN(PH_G5)) {
        convert_weight(p.in[17], 4096, DM, (bf16_t*)(ws + WS_WT6), nullptr, 0, scr, gw, ngw, lane);
        convert_weight(p.in[18] + (size_t)DM * FF, DM, FF, (bf16_t*)(ws + WS_WT7), p.in[3] + DM, 1, scr, gw, ngw, lane);
        convert_weight(p.in[19] + (size_t)DM * FF, DM, FF, (bf16_t*)(ws + WS_WT7), p.in[3] + DM, 2, scr, gw, ngw, lane);
        convert_weight(p.in[20] + (size_t)FF * DM, FF, DM, (bf16_t*)(ws + WS_WT8), nullptr, 0, scr, gw, ngw, lane);
        __syncthreads();
        pg8::Gemm g{hb, (const bf16_t*)(ws + WS_WT5), T, 8192, DM}; pg8::StaticOrder S; S.init(T, 8192, G, (int)blockIdx.x);
        EpiMlIn E{(bf16_t*)(ws + WS_XM), (bf16_t*)(ws + WS_Z), sumsq + 2 * T};
        pg8::gemm_phase(lds, g, S, E);
    }
#endif
    SEAM(PH_G5);
    if (IN(PH_MC)) {
        const bf16_t* XM = (const bf16_t*)(ws + WS_XM); bf16_t* XC = (bf16_t*)(ws + WS_XC);
        const bf16_t* wch = (const bf16_t*)(ws + WS_WGC); const bf16_t* wcl = wch + 32768; const bf16_t* wmh = (const bf16_t*)(ws + WS_WGM); const bf16_t* wml = wmh + 32768;
        float* GA = (float*)(ws + WS_GA); float* GPM = (float*)(ws + WS_GPM); float* GB = (float*)(ws + WS_GB); float* BL = (float*)(ws + WS_BLAST); float* PL = (float*)(ws + WS_PML);
        LAS unsigned char* img0 = lds;
        LAS float* l_gp = (LAS float*)(lds + 81920);
        LAS float* l_ig = l_gp + 2048;
        LAS float* l_lf = l_ig + 512;
        const int r = lane & 31, hh = lane >> 5, rb = wave & 3, chh = wave >> 2;
        const int dslot = (tid & 15) ^ ((tid >> 4) & 15);
        LAS bf16_t* l_gw = (LAS bf16_t*)(lds + 94208); LAS float* l_cwb = (LAS float*)(lds + 94208 + 2 * 8704);
        const int wg_arr = tid >> 7, wg_row = (tid >> 4) & 7, wg_ch = tid & 15;
        const bf16_t* wg_src = (wg_arr == 0 ? wch : wg_arr == 1 ? wcl : wg_arr == 2 ? wmh : wml) + (size_t)wg_row * 4096 + wg_ch * 8;
        const float* cw_src = (tid < 128 ? p.in[8] + (size_t)(tid >> 5) * 4096 : p.in[9]) + (tid & 31) * 4;
        for (int cb = blockIdx.x; cb < NCB; cb += G) {
            const size_t row0 = (size_t)cb * 128; const bool first = (cb & 127) == 0;
            const int lr = 32 * rb + r; const size_t trow = row0 + lr;
            const bool ok0 = !first || lr >= 3, ok1 = !first || lr >= 2, ok2 = !first || lr >= 1;
            const bf16_t* dma_lo = XM + (first ? row0 + (size_t)(tid >> 4) : row0 - 32 + (size_t)(tid >> 4)) * 4096 + dslot * 8;
            const bf16_t* dma_hi = XM + (row0 + (size_t)(tid >> 4)) * 4096 + dslot * 8;
#define MC_ISSUE(bufi, stp) do { LAS unsigned char* d_ = img0 + (bufi) * 40960 + wave * 1024; \
            __builtin_amdgcn_global_load_lds((const unsigned*)(dma_lo + (stp) * 128), (LAS unsigned*)d_, 16, 0, 0); \
            _Pragma("unroll") for (int j_ = 0; j_ < 4; ++j_) __builtin_amdgcn_global_load_lds((const unsigned*)(dma_hi + (size_t)j_ * 32 * 4096 + (stp) * 128), (LAS unsigned*)(d_ + (j_ + 1) * 8192), 16, 0, 0); } while (0)
            f32x16 acc;
#pragma unroll
            for (int i = 0; i < 16; ++i) acc[i] = 0.f;
            const u32x4 zz4 = {0u, 0u, 0u, 0u};
            MC_ISSUE(0, 0);
            { *(LAS u32x4*)(l_gw + (wg_arr * 8 + wg_row) * 136 + wg_ch * 8) = *(const u32x4*)wg_src; if (tid < 160) *(LAS f32x4*)(l_cwb + (tid >> 5) * 128 + (tid & 31) * 4) = *(const f32x4*)cw_src; }
#pragma unroll 1
            for (int step = 0; step < 32; ++step) {
                const int sn = step + 1 < 32 ? step + 1 : step;
                if (step + 1 < 32) MC_ISSUE((step + 1) & 1, step + 1);
                const u32x4 nwg = *(const u32x4*)(wg_src + sn * 128); f32x4 ncw = {0.f, 0.f, 0.f, 0.f}; if (tid < 160) ncw = *(const f32x4*)(cw_src + sn * 128);
                if (step + 1 < 32) asm volatile("s_waitcnt vmcnt(6)" ::: "memory");
                else asm volatile("s_waitcnt vmcnt(0)" ::: "memory");
                __syncthreads();
                const LAS unsigned char* im = img0 + (step & 1) * 40960;
                const LAS bf16_t* gwb = l_gw + (step & 1) * 4352; const LAS float* cwb = l_cwb + (step & 1) * 640;
#pragma unroll
                for (int q = 0; q < 4; ++q) {
                    const int gl = chh * 4 + q, ch = step * 128 + 16 * gl + 8 * hh, cc = 2 * gl + hh;
                    const int i0 = 29 + lr;
                    const u32x4 c0 = ok0 ? *(const LAS u32x4*)(im + (i0) * 256 + ((cc ^ ((i0) & 15)) * 16)) : zz4;
                    const u32x4 c1 = ok1 ? *(const LAS u32x4*)(im + (i0 + 1) * 256 + ((cc ^ ((i0 + 1) & 15)) * 16)) : zz4;
                    const u32x4 c2 = ok2 ? *(const LAS u32x4*)(im + (i0 + 2) * 256 + ((cc ^ ((i0 + 2) & 15)) * 16)) : zz4;
                    const u32x4 c3 = *(const LAS u32x4*)(im + (i0 + 3) * 256 + ((cc ^ ((i0 + 3) & 15)) * 16));
                    float w0[8], w1[8], w2[8], w3[8], xc[8];
                    unpack8(c0, w0); unpack8(c1, w1); unpack8(c2, w2); unpack8(c3, w3);
#pragma unroll
                    for (int q4 = 0; q4 < 2; ++q4) {
                        const int cl = 16 * gl + 8 * hh + 4 * q4;
                        const f32x4 k0 = *(const LAS f32x4*)(cwb + cl), k1 = *(const LAS f32x4*)(cwb + 128 + cl), k2 = *(const LAS f32x4*)(cwb + 256 + cl), k3 = *(const LAS f32x4*)(cwb + 384 + cl);
                        const f32x4 bb = *(const LAS f32x4*)(cwb + 512 + cl);
#pragma unroll
                        for (int e = 0; e < 4; ++e) xc[4 * q4 + e] = silu_f(bb[e] + w0[4 * q4 + e] * k0[e] + w1[4 * q4 + e] * k1[e] + w2[4 * q4 + e] * k2[e] + w3[4 * q4 + e] * k3[e]);
                    }
                    const u32x4 xh = pack8f(xc);
                    *(u32x4*)(XC + trow * 4096 + ch) = xh;
                    float xr[8], xhf[8]; unpack8(xh, xhf);
#pragma unroll
                    for (int e = 0; e < 8; ++e) xr[e] = xc[e] - xhf[e];
                    const u32x4 xl = pack8f(xr);
                    const int wo = (r & 7) * 136 + 16 * gl + 8 * hh;
                    bf16x8 bch = *(const LAS bf16x8*)(gwb + wo), bcl = *(const LAS bf16x8*)(gwb + 8 * 136 + wo), bmh = *(const LAS bf16x8*)(gwb + 16 * 136 + wo), bml = *(const LAS bf16x8*)(gwb + 24 * 136 + wo);
                    if (r >= 8) { bch = bcl = bmh = bml = (bf16x8){0, 0, 0, 0, 0, 0, 0, 0}; }
                    const bf16x8 ah = __builtin_bit_cast(bf16x8, xh), al = __builtin_bit_cast(bf16x8, xl), am = __builtin_bit_cast(bf16x8, c3);
                    acc = MFMA32(ah, bch, acc); acc = MFMA32(ah, bcl, acc); acc = MFMA32(al, bch, acc); acc = MFMA32(am, bmh, acc); acc = MFMA32(am, bml, acc);
                }
                { const int nb = (step + 1) & 1; *(LAS u32x4*)(l_gw + nb * 4352 + (wg_arr * 8 + wg_row) * 136 + wg_ch * 8) = nwg; if (tid < 160) *(LAS f32x4*)(l_cwb + nb * 640 + (tid >> 5) * 128 + (tid & 31) * 4) = ncw; }
                __syncthreads();
            }
#undef MC_ISSUE
            if (r < 8) {
#pragma unroll
                for (int i = 0; i < 16; ++i) l_gp[(chh * 128 + 32 * rb + crow(i, hh)) * 8 + r] = acc[i];
            }
            __syncthreads();
            if (tid < 128) {
#pragma unroll
                for (int g = 0; g < 8; ++g) { const float sg = (l_gp[tid * 8 + g] + l_gp[(128 + tid) * 8 + g]) + p.in[14][g];
                    if (g < 4) l_ig[g * 128 + tid] = sg; else l_lf[(g - 4) * 128 + tid] = fminf(sg, 0.f) - log1pf(__expf(-fabsf(sg))); }
            }
            __syncthreads();
            if (wave < 4) {
                const int h = wave; const float f0 = l_lf[h * 128 + 2 * lane], f1 = l_lf[h * 128 + 2 * lane + 1];
                float x = f0 + f1;
#pragma unroll
                for (int d = 1; d < 64; d <<= 1) { const float v = __shfl_up(x, d); if (lane >= d) x += v; }
                const float b1 = x, b0 = x - f1;
                const float a0 = l_ig[h * 128 + 2 * lane] - b0, a1 = l_ig[h * 128 + 2 * lane + 1] - b1;
                float mx = fmaxf(a0, a1);
#pragma unroll
                for (int d = 1; d < 64; d <<= 1) { const float v = __shfl_up(mx, d); if (lane >= d) mx = fmaxf(mx, v); }
                float mprev = __shfl_up(mx, 1); if (lane == 0) mprev = -INFINITY;
                const float pm0 = fmaxf(mprev, a0), pm1 = mx;
                const size_t o0 = (row0 + 2 * lane) * 4 + h, o1 = o0 + 4;
                GB[o0] = b0; GB[o1] = b1; GA[o0] = a0; GA[o1] = a1; GPM[o0] = pm0; GPM[o1] = pm1;
                if (lane == 63) { BL[cb * 4 + h] = b1; PL[cb * 4 + h] = pm1; }
            }
            __syncthreads();
        }
    }
#if (REP_MASK >> 9) & 1
    grid.sync();
    if (IN(PH_MC)) {
        const bf16_t* XM = (const bf16_t*)(ws + WS_XM); bf16_t* XC = (bf16_t*)(ws + WS_XC);
        const bf16_t* wch = (const bf16_t*)(ws + WS_WGC); const bf16_t* wcl = wch + 32768; const bf16_t* wmh = (const bf16_t*)(ws + WS_WGM); const bf16_t* wml = wmh + 32768;
        float* GA = (float*)(ws + WS_GA); float* GPM = (float*)(ws + WS_GPM); float* GB = (float*)(ws + WS_GB); float* BL = (float*)(ws + WS_BLAST); float* PL = (float*)(ws + WS_PML);
        LAS unsigned char* img0 = lds;
        LAS float* l_gp = (LAS float*)(lds + 81920);
        LAS float* l_ig = l_gp + 2048;
        LAS float* l_lf = l_ig + 512;
        const int r = lane & 31, hh = lane >> 5, rb = wave & 3, chh = wave >> 2;
        const int dslot = (tid & 15) ^ ((tid >> 4) & 15);
        LAS bf16_t* l_gw = (LAS bf16_t*)(lds + 94208); LAS float* l_cwb = (LAS float*)(lds + 94208 + 2 * 8704);
        const int wg_arr = tid >> 7, wg_row = (tid >> 4) & 7, wg_ch = tid & 15;
        const bf16_t* wg_src = (wg_arr == 0 ? wch : wg_arr == 1 ? wcl : wg_arr == 2 ? wmh : wml) + (size_t)wg_row * 4096 + wg_ch * 8;
        const float* cw_src = (tid < 128 ? p.in[8] + (size_t)(tid >> 5) * 4096 : p.in[9]) + (tid & 31) * 4;
        for (int cb = blockIdx.x; cb < NCB; cb += G) {
            const size_t row0 = (size_t)cb * 128; const bool first = (cb & 127) == 0;
            const int lr = 32 * rb + r; const size_t trow = row0 + lr;
            const bool ok0 = !first || lr >= 3, ok1 = !first || lr >= 2, ok2 = !first || lr >= 1;
            const bf16_t* dma_lo = XM + (first ? row0 + (size_t)(tid >> 4) : row0 - 32 + (size_t)(tid >> 4)) * 4096 + dslot * 8;
            const bf16_t* dma_hi = XM + (row0 + (size_t)(tid >> 4)) * 4096 + dslot * 8;
#define MC_ISSUE(bufi, stp) do { LAS unsigned char* d_ = img0 + (bufi) * 40960 + wave * 1024; \
            __builtin_amdgcn_global_load_lds((const unsigned*)(dma_lo + (stp) * 128), (LAS unsigned*)d_, 16, 0, 0); \
            _Pragma("unroll") for (int j_ = 0; j_ < 4; ++j_) __builtin_amdgcn_global_load_lds((const unsigned*)(dma_hi + (size_t)j_ * 32 * 4096 + (stp) * 128), (LAS unsigned*)(d_ + (j_ + 1) * 8192), 16, 0, 0); } while (0)
            f32x16 acc;
#pragma unroll
            for (int i = 0; i < 16; ++i) acc[i] = 0.f;
            const u32x4 zz4 = {0u, 0u, 0u, 0u};
            MC_ISSUE(0, 0);
            { *(LAS u32x4*)(l_gw + (wg_arr * 8 + wg_row) * 136 + wg_ch * 8) = *(const u32x4*)wg_src; if (tid < 160) *(LAS f32x4*)(l_cwb + (tid >> 5) * 128 + (tid & 31) * 4) = *(const f32x4*)cw_src; }
#pragma unroll 1
            for (int step = 0; step < 32; ++step) {
                const int sn = step + 1 < 32 ? step + 1 : step;
                if (step + 1 < 32) MC_ISSUE((step + 1) & 1, step + 1);
                const u32x4 nwg = *(const u32x4*)(wg_src + sn * 128); f32x4 ncw = {0.f, 0.f, 0.f, 0.f}; if (tid < 160) ncw = *(const f32x4*)(cw_src + sn * 128);
                if (step + 1 < 32) asm volatile("s_waitcnt vmcnt(6)" ::: "memory");
                else asm volatile("s_waitcnt vmcnt(0)" ::: "memory");
                __syncthreads();
                const LAS unsigned char* im = img0 + (step & 1) * 40960;
                const LAS bf16_t* gwb = l_gw + (step & 1) * 4352; const LAS float* cwb = l_cwb + (step & 1) * 640;
#pragma unroll
                for (int q = 0; q < 4; ++q) {
                    const int gl = chh * 4 + q, ch = step * 128 + 16 * gl + 8 * hh, cc = 2 * gl + hh;
                    const int i0 = 29 + lr;
                    const u32x4 c0 = ok0 ? *(const LAS u32x4*)(im + (i0) * 256 + ((cc ^ ((i0) & 15)) * 16)) : zz4;
                    const u32x4 c1 = ok1 ? *(const LAS u32x4*)(im + (i0 + 1) * 256 + ((cc ^ ((i0 + 1) & 15)) * 16)) : zz4;
                    const u32x4 c2 = ok2 ? *(const LAS u32x4*)(im + (i0 + 2) * 256 + ((cc ^ ((i0 + 2) & 15)) * 16)) : zz4;
                    const u32x4 c3 = *(const LAS u32x4*)(im + (i0 + 3) * 256 + ((cc ^ ((i0 + 3) & 15)) * 16));
                    float w0[8], w1[8], w2[8], w3[8], xc[8];
                    unpack8(c0, w0); unpack8(c1, w1); unpack8(c2, w2); unpack8(c3, w3);
#pragma unroll
                    for (int q4 = 0; q4 < 2; ++q4) {
                        const int cl = 16 * gl + 8 * hh + 4 * q4;
                        const f32x4 k0 = *(const LAS f32x4*)(cwb + cl), k1 = *(const LAS f32x4*)(cwb + 128 + cl), k2 = *(const LAS f32x4*)(cwb + 256 + cl), k3 = *(const LAS f32x4*)(cwb + 384 + cl);
                        const f32x4 bb = *(const LAS f32x4*)(cwb + 512 + cl);
#pragma unroll
                        for (int e = 0; e < 4; ++e) xc[4 * q4 + e] = silu_f(bb[e] + w0[4 * q4 + e] * k0[e] + w1[4 * q4 + e] * k1[e] + w2[4 * q4 + e] * k2[e] + w3[4 * q4 + e] * k3[e]);
                    }
                    const u32x4 xh = pack8f(xc);
                    *(u32x4*)(XC + trow * 4096 + ch) = xh;
                    float xr[8], xhf[8]; unpack8(xh, xhf);
#pragma unroll
                    for (int e = 0; e < 8; ++e) xr[e] = xc[e] - xhf[e];
                    const u32x4 xl = pack8f(xr);
                    const int wo = (r & 7) * 136 + 16 * gl + 8 * hh;
                    bf16x8 bch = *(const LAS bf16x8*)(gwb + wo), bcl = *(const LAS bf16x8*)(gwb + 8 * 136 + wo), bmh = *(const LAS bf16x8*)(gwb + 16 * 136 + wo), bml = *(const LAS bf16x8*)(gwb + 24 * 136 + wo);
                    if (r >= 8) { bch = bcl = bmh = bml = (bf16x8){0, 0, 0, 0, 0, 0, 0, 0}; }
                    const bf16x8 ah = __builtin_bit_cast(bf16x8, xh), al = __builtin_bit_cast(bf16x8, xl), am = __builtin_bit_cast(bf16x8, c3);
                    acc = MFMA32(ah, bch, acc); acc = MFMA32(ah, bcl, acc); acc = MFMA32(al, bch, acc); acc = MFMA32(am, bmh, acc); acc = MFMA32(am, bml, acc);
                }
                { const int nb = (step + 1) & 1; *(LAS u32x4*)(l_gw + nb * 4352 + (wg_arr * 8 + wg_row) * 136 + wg_ch * 8) = nwg; if (tid < 160) *(LAS f32x4*)(l_cwb + nb * 640 + (tid >> 5) * 128 + (tid & 31) * 4) = ncw; }
                __syncthreads();
            }
#undef MC_ISSUE
            if (r < 8) {
#pragma unroll
                for (int i = 0; i < 16; ++i) l_gp[(chh * 128 + 32 * rb + crow(i, hh)) * 8 + r] = acc[i];
            }
            __syncthreads();
            if (tid < 128) {
#pragma unroll
                for (int g = 0; g < 8; ++g) { const float sg = (l_gp[tid * 8 + g] + l_gp[(128 + tid) * 8 + g]) + p.in[14][g];
                    if (g < 4) l_ig[g * 128 + tid] = sg; else l_lf[(g - 4) * 128 + tid] = fminf(sg, 0.f) - log1pf(__expf(-fabsf(sg))); }
            }
            __syncthreads();
            if (wave < 4) {
                const int h = wave; const float f0 = l_lf[h * 128 + 2 * lane], f1 = l_lf[h * 128 + 2 * lane + 1];
                float x = f0 + f1;
#pragma unroll
                for (int d = 1; d < 64; d <<= 1) { const float v = __shfl_up(x, d); if (lane >= d) x += v; }
                const float b1 = x, b0 = x - f1;
                const float a0 = l_ig[h * 128 + 2 * lane] - b0, a1 = l_ig[h * 128 + 2 * lane + 1] - b1;
                float mx = fmaxf(a0, a1);
#pragma unroll
                for (int d = 1; d < 64; d <<= 1) { const float v = __shfl_up(mx, d); if (lane >= d) mx = fmaxf(mx, v); }
                float mprev = __shfl_up(mx, 1); if (lane == 0) mprev = -INFINITY;
                const float pm0 = fmaxf(mprev, a0), pm1 = mx;
                const size_t o0 = (row0 + 2 * lane) * 4 + h, o1 = o0 + 4;
                GB[o0] = b0; GB[o1] = b1; GA[o0] = a0; GA[o1] = a1; GPM[o0] = pm0; GPM[o1] = pm1;
                if (lane == 63) { BL[cb * 4 + h] = b1; PL[cb * 4 + h] = pm1; }
            }
            __syncthreads();
        }
    }
#endif
    SEAM(PH_MC);
    if (IN(PH_MP)) {
        phase_scores<32, true>((const bf16_t*)(ws + WS_XC), (const bf16_t*)(ws + WS_XC), 4096, nullptr, (const u32x2*)(ws + WS_BDQC), (const u32x2*)(ws + WS_BDKC), 4, (bf16_t*)(dob + DO_PML1),
                               (const float*)(ws + WS_GA), (const float*)(ws + WS_GPM), (const float*)(ws + WS_GB), (const float*)(ws + WS_BLAST), (const float*)(ws + WS_PML), (float*)(ws + WS_DENA), (float*)(ws + WS_EMT), (float*)(ws + WS_DENI), (float*)(dob + DO_INTER2), (float*)(ws + WS_CW), (float*)(ws + WS_DEC), (float*)(dob + DO_KW), lds);
    }
#if (REP_MASK >> 10) & 1
    grid.sync();
    if (IN(PH_MP)) {
        phase_scores<32, true>((const bf16_t*)(ws + WS_XC), (const bf16_t*)(ws + WS_XC), 4096, nullptr, (const u32x2*)(ws + WS_BDQC), (const u32x2*)(ws + WS_BDKC), 4, (bf16_t*)(dob + DO_PML1),
                               (const float*)(ws + WS_GA), (const float*)(ws + WS_GPM), (const float*)(ws + WS_GB), (const float*)(ws + WS_BLAST), (const float*)(ws + WS_PML), (float*)(ws + WS_DENA), (float*)(ws + WS_EMT), (float*)(ws + WS_DENI), (float*)(dob + DO_INTER2), (float*)(ws + WS_CW), (float*)(ws + WS_DEC), (float*)(dob + DO_KW), lds);
    }
#endif
    SEAM(PH_MP);
    if (IN(PH_MS)) {
        { const float* KW = (const float*)(dob + DO_KW); float* NPV = (float*)(dob + DO_NPREV); const float* DEC = (const float*)(ws + WS_DEC);
            for (int idx = (int)gtid; idx < 8192; idx += (int)gthreads) { const int bh = idx >> 10, dk = idx & 1023, b = bh >> 2, h = bh & 3; float nv = 0.f;
#pragma unroll 8
                for (int c = 0; c < 128; ++c) { const size_t o = (size_t)((b * 128 + c) * 4 + h) * 1024 + dk; NPV[o] = nv; nv = DEC[(b * 128 + c) * 4 + h] * nv + KW[o]; } } }
        phase_scan<4, true>((const bf16_t*)(ws + WS_XC), (const bf16_t*)(ws + WS_XC), 4096, (const bf16_t*)(ws + WS_BDQ), (const bf16_t*)(ws + WS_BDK), 4, 1024, (bf16_t*)(ws + WS_XM), (const bf16_t*)(dob + DO_PML1),
                            p.in[12], (const float*)(ws + WS_DENI), (const float*)(dob + DO_INTER2), (const float*)(ws + WS_CW), (const float*)(ws + WS_DEC), lds, !((REP_MASK >> 11) & 1));
    }
#if (REP_MASK >> 11) & 1
    grid.sync();
    if (IN(PH_MS)) {
        { const float* KW = (const float*)(dob + DO_KW); float* NPV = (float*)(dob + DO_NPREV); const float* DEC = (const float*)(ws + WS_DEC);
            for (int idx = (int)gtid; idx < 8192; idx += (int)gthreads) { const int bh = idx >> 10, dk = idx & 1023, b = bh >> 2, h = bh & 3; float nv = 0.f;
#pragma unroll 8
                for (int c = 0; c < 128; ++c) { const size_t o = (size_t)((b * 128 + c) * 4 + h) * 1024 + dk; NPV[o] = nv; nv = DEC[(b * 128 + c) * 4 + h] * nv + KW[o]; } } }
        phase_scan<4, true>((const bf16_t*)(ws + WS_XC), (const bf16_t*)(ws + WS_XC), 4096, (const bf16_t*)(ws + WS_BDQ), (const bf16_t*)(ws + WS_BDK), 4, 1024, (bf16_t*)(ws + WS_XM), (const bf16_t*)(dob + DO_PML1),
                            p.in[12], (const float*)(ws + WS_DENI), (const float*)(dob + DO_INTER2), (const float*)(ws + WS_CW), (const float*)(ws + WS_DEC), lds);
    }
#endif
    SEAM(PH_MS);
    if (IN(PH_MF)) {
        const bf16_t* O = (const bf16_t*)(ws + WS_XM); bf16_t* Zt = (bf16_t*)(ws + WS_Z); const bf16_t* XC = (const bf16_t*)(ws + WS_XC);
        const float* dena = (const float*)(ws + WS_DENA); const float* deni = (const float*)(ws + WS_DENI); const float* emt = (const float*)(ws + WS_EMT);
        const float* gn = p.in[15]; const float* sk = p.in[16];
        const float* NPV = (const float*)(dob + DO_NPREV);
        {
            const int h = gw & 3;
            f32x4 wq4[2][8];
#pragma unroll
            for (int k = 0; k < 2; ++k) { const int c = h * 1024 + k * 512 + lane * 8;
#pragma unroll
                for (int j = 0; j < 8; ++j) wq4[k][j] = *((const f32x4*)(p.in[10] + (size_t)(c >> 2) * 16) + j);
            }
            const bool mf_store_ = ((REP_MASK >> 12) & 1) ? (mf_pass_++ > 0) : true;
            const int nrw_ = (T + (ngw >> 2) - 1) / (ngw >> 2), rowA_ = (gw >> 2) * nrw_;
            const int rowA = rowA_ < T ? rowA_ : T - 1, nrw = rowA_ >= T ? 0 : (rowA_ + nrw_ <= T ? nrw_ : T - rowA_);
            const size_t cbase = (size_t)h * 1024 + lane * 8;
            f32x4 nv[2][2];
#pragma unroll
            for (int k = 0; k < 2; ++k) { const f32x4* np4 = (const f32x4*)(NPV + (size_t)((rowA >> 7) * 4 + h) * 1024 + k * 512 + lane * 8); nv[k][0] = np4[0]; nv[k][1] = np4[1]; }
            u32x4 nxc[2], nxo[2], nxz[2]; float nda, ndi, nem;
#pragma unroll
            for (int k = 0; k < 2; ++k) { const size_t off = (size_t)rowA * 4096 + cbase + k * 512; nxc[k] = *(const u32x4*)(XC + off); nxo[k] = *(const u32x4*)(O + off); nxz[k] = *(const u32x4*)(Zt + off); }
            nda = dena[(size_t)rowA * 4 + h]; ndi = deni[(size_t)rowA * 4 + h]; nem = emt[(size_t)rowA * 4 + h];
#pragma unroll 1
            for (int ri = 0; ri < nrw; ++ri) {
                const int row = rowA + ri, rown = ri + 1 < nrw ? row + 1 : row;
                if (((row & 127) == 0) && ri) {
#pragma unroll
                    for (int k = 0; k < 2; ++k) { const f32x4* np4 = (const f32x4*)(NPV + (size_t)((row >> 7) * 4 + h) * 1024 + k * 512 + lane * 8); nv[k][0] = np4[0]; nv[k][1] = np4[1]; }
                }
                const u32x4 cxc0 = nxc[0], cxc1 = nxc[1], cxo0 = nxo[0], cxo1 = nxo[1], cxz0 = nxz[0], cxz1 = nxz[1]; const float cda = nda, cdi = ndi, cem = nem;
#pragma unroll
                for (int k = 0; k < 2; ++k) { const size_t off = (size_t)rown * 4096 + cbase + k * 512; nxc[k] = *(const u32x4*)(XC + off); nxo[k] = *(const u32x4*)(O + off); nxz[k] = *(const u32x4*)(Zt + off); }
                nda = dena[(size_t)rown * 4 + h]; ndi = deni[(size_t)rown * 4 + h]; nem = emt[(size_t)rown * 4 + h];
                float x8[2][8], o[16], qn = 0.f;
#pragma unroll
                for (int k = 0; k < 2; ++k) {
                    unpack8(k ? cxc1 : cxc0, x8[k]);
#pragma unroll
                    for (int bl = 0; bl < 2; ++bl)
#pragma unroll
                        for (int oo = 0; oo < 4; ++oo) { const f32x4 w4 = wq4[k][bl * 4 + oo];
                            const float qv = w4[0] * x8[k][4 * bl] + w4[1] * x8[k][4 * bl + 1] + w4[2] * x8[k][4 * bl + 2] + w4[3] * x8[k][4 * bl + 3];
                            qn += qv * nv[k][bl][oo]; }
                    float t8[8]; unpack8(k ? cxo1 : cxo0, t8);
#pragma unroll
                    for (int e2 = 0; e2 < 8; ++e2) o[8 * k + e2] = t8[e2];
                }
                qn = wave_sum(qn);
                const float den = cda + cdi * qn;
                const float inv = 1.0f / fmaxf(fabsf(den), cem);
                float sm = 0.f;
#pragma unroll
                for (int e2 = 0; e2 < 16; ++e2) { o[e2] *= inv; sm += o[e2]; }
                const float mu = wave_sum(sm) * (1.f / 1024.f); float q = 0.f;
#pragma unroll
                for (int e2 = 0; e2 < 16; ++e2) { o[e2] -= mu; q += o[e2] * o[e2]; }
                const float rstd = rsqrtf(wave_sum(q) * (1.f / 1024.f) + EPSN);
#pragma unroll
                for (int k = 0; k < 2; ++k) {
                    const int c = h * 1024 + k * 512 + lane * 8; const size_t off = (size_t)row * 4096 + c;
                    float z8[8], y[8]; unpack8(k ? cxz1 : cxz0, z8);
                    const f32x4 g0 = *(const f32x4*)(gn + c), g1 = *(const f32x4*)(gn + c + 4), s0 = *(const f32x4*)(sk + c), s1 = *(const f32x4*)(sk + c + 4);
#pragma unroll
                    for (int e2 = 0; e2 < 8; ++e2) y[e2] = (o[8 * k + e2] * rstd * (e2 < 4 ? g0[e2 & 3] : g1[e2 & 3]) + (e2 < 4 ? s0[e2 & 3] : s1[e2 & 3]) * x8[k][e2]) * silu_f(z8[e2]);
                    if (mf_store_) *(u32x4*)(Zt + off) = pack8f(y);
                }
            }
        }
    }
#if (REP_MASK >> 12) & 1
    grid.sync();
    if (IN(PH_MF)) {
        const bf16_t* O = (const bf16_t*)(ws + WS_XM); bf16_t* Zt = (bf16_t*)(ws + WS_Z); const bf16_t* XC = (const bf16_t*)(ws + WS_XC);
        const float* dena = (const float*)(ws + WS_DENA); const float* deni = (const float*)(ws + WS_DENI); const float* emt = (const float*)(ws + WS_EMT);
        const float* gn = p.in[15]; const float* sk = p.in[16];
        const float* NPV = (const float*)(dob + DO_NPREV);
        {
            const int h = gw & 3;
            f32x4 wq4[2][8];
#pragma unroll
            for (int k = 0; k < 2; ++k) { const int c = h * 1024 + k * 512 + lane * 8;
#pragma unroll
                for (int j = 0; j < 8; ++j) wq4[k][j] = *((const f32x4*)(p.in[10] + (size_t)(c >> 2) * 16) + j);
            }
            const bool mf_store_ = ((REP_MASK >> 12) & 1) ? (mf_pass_++ > 0) : true;
            const int nrw_ = (T + (ngw >> 2) - 1) / (ngw >> 2), rowA_ = (gw >> 2) * nrw_;
            const int rowA = rowA_ < T ? rowA_ : T - 1, nrw = rowA_ >= T ? 0 : (rowA_ + nrw_ <= T ? nrw_ : T - rowA_);
            const size_t cbase = (size_t)h * 1024 + lane * 8;
            f32x4 nv[2][2];
#pragma unroll
            for (int k = 0; k < 2; ++k) { const f32x4* np4 = (const f32x4*)(NPV + (size_t)((rowA >> 7) * 4 + h) * 1024 + k * 512 + lane * 8); nv[k][0] = np4[0]; nv[k][1] = np4[1]; }
            u32x4 nxc[2], nxo[2], nxz[2]; float nda, ndi, nem;
#pragma unroll
            for (int k = 0; k < 2; ++k) { const size_t off = (size_t)rowA * 4096 + cbase + k * 512; nxc[k] = *(const u32x4*)(XC + off); nxo[k] = *(const u32x4*)(O + off); nxz[k] = *(const u32x4*)(Zt + off); }
            nda = dena[(size_t)rowA * 4 + h]; ndi = deni[(size_t)rowA * 4 + h]; nem = emt[(size_t)rowA * 4 + h];
#pragma unroll 1
            for (int ri = 0; ri < nrw; ++ri) {
                const int row = rowA + ri, rown = ri + 1 < nrw ? row + 1 : row;
                if (((row & 127) == 0) && ri) {
#pragma unroll
                    for (int k = 0; k < 2; ++k) { const f32x4* np4 = (const f32x4*)(NPV + (size_t)((row >> 7) * 4 + h) * 1024 + k * 512 + lane * 8); nv[k][0] = np4[0]; nv[k][1] = np4[1]; }
                }
                const u32x4 cxc0 = nxc[0], cxc1 = nxc[1], cxo0 = nxo[0], cxo1 = nxo[1], cxz0 = nxz[0], cxz1 = nxz[1]; const float cda = nda, cdi = ndi, cem = nem;
#pragma unroll
                for (int k = 0; k < 2; ++k) { const size_t off = (size_t)rown * 4096 + cbase + k * 512; nxc[k] = *(const u32x4*)(XC + off); nxo[k] = *(const u32x4*)(O + off); nxz[k] = *(const u32x4*)(Zt + off); }
                nda = dena[(size_t)rown * 4 + h]; ndi = deni[(size_t)rown * 4 + h]; nem = emt[(size_t)rown * 4 + h];
                float x8[2][8], o[16], qn = 0.f;
#pragma unroll
                for (int k = 0; k < 2; ++k) {
                    unpack8(k ? cxc1 : cxc0, x8[k]);
#pragma unroll
                    for (int bl = 0; bl < 2; ++bl)
#pragma unroll
                        for (int oo = 0; oo < 4; ++oo) { const f32x4 w4 = wq4[k][bl * 4 + oo];
                            const float qv = w4[0] * x8[k][4 * bl] + w4[1] * x8[k][4 * bl + 1] + w4[2] * x8[k][4 * bl + 2] + w4[3] * x8[k][4 * bl + 3];
                            qn += qv * nv[k][bl][oo]; }
                    float t8[8]; unpack8(k ? cxo1 : cxo0, t8);
#pragma unroll
                    for (int e2 = 0; e2 < 8; ++e2) o[8 * k + e2] = t8[e2];
                }
                qn = wave_sum(qn);
                const float den = cda + cdi * qn;
                const float inv = 1.0f / fmaxf(fabsf(den), cem);
                float sm = 0.f;
#pragma unroll
                for (int e2 = 0; e2 < 16; ++e2) { o[e2] *= inv; sm += o[e2]; }
                const float mu = wave_sum(sm) * (1.f / 1024.f); float q = 0.f;
#pragma unroll
                for (int e2 = 0; e2 < 16; ++e2) { o[e2] -= mu; q += o[e2] * o[e2]; }
                const float rstd = rsqrtf(wave_sum(q) * (1.f / 1024.f) + EPSN);
#pragma unroll
                for (int k = 0; k < 2; ++k) {
                    const int c = h * 1024 + k * 512 + lane * 8; const size_t off = (size_t)row * 4096 + c;
                    float z8[8], y[8]; unpack8(k ? cxz1 : cxz0, z8);
                    const f32x4 g0 = *(const f32x4*)(gn + c), g1 = *(const f32x4*)(gn + c + 4), s0 = *(const f32x4*)(sk + c), s1 = *(const f32x4*)(sk + c + 4);
#pragma unroll
                    for (int e2 = 0; e2 < 8; ++e2) y[e2] = (o[8 * k + e2] * rstd * (e2 < 4 ? g0[e2 & 3] : g1[e2 & 3]) + (e2 < 4 ? s0[e2 & 3] : s1[e2 & 3]) * x8[k][e2]) * silu_f(z8[e2]);
                    if (mf_store_) *(u32x4*)(Zt + off) = pack8f(y);
                }
            }
        }
    }
#endif
    SEAM(PH_MF);
    if (IN(PH_G6)) {
        pg8::Gemm g{(const bf16_t*)(ws + WS_Z), (const bf16_t*)(ws + WS_WT6), T, DM, 4096}; pg8::StaticOrder S; S.init(T, DM, G, (int)blockIdx.x);
        EpiResid E{hb, sumsq + 3 * T};
        pg8::gemm_phase(lds, g, S, E);
    }
#if (REP_MASK >> 13) & 1
    grid.sync();
    if (IN(PH_G6)) {
        pg8::Gemm g{(const bf16_t*)(ws + WS_Z), (const bf16_t*)(ws + WS_WT6), T, DM, 4096}; pg8::StaticOrder S; S.init(T, DM, G, (int)blockIdx.x);
        EpiResid E{hb, sumsq + 3 * T};
        pg8::gemm_phase(lds, g, S, E);
    }
#endif
    SEAM(PH_G6);
    if (IN(PH_G7)) {
        pg8::Gemm g{hb, (const bf16_t*)(ws + WS_WT7), T, 2 * FF, DM}; pg8::StaticOrder S; S.init(T, 2 * FF, G, (int)blockIdx.x);
        EpiSwiGLU E{(bf16_t*)(ws + WS_ACT1), sumsq + 3 * T};
        pg8::gemm_phase(lds, g, S, E);
    }
#if (REP_MASK >> 14) & 1
    grid.sync();
    if (IN(PH_G7)) {
        pg8::Gemm g{hb, (const bf16_t*)(ws + WS_WT7), T, 2 * FF, DM}; pg8::StaticOrder S; S.init(T, 2 * FF, G, (int)blockIdx.x);
        EpiSwiGLU E{(bf16_t*)(ws + WS_ACT1), sumsq + 3 * T};
        pg8::gemm_phase(lds, g, S, E);
    }
#endif
    SEAM(PH_G7);
    if (IN(PH_G8)) {
        pg8::Gemm g{(const bf16_t*)(ws + WS_ACT1), (const bf16_t*)(ws + WS_WT8), T, DM, FF}; pg8::StaticOrder S; S.init(T, DM, G, (int)blockIdx.x);
        EpiResid E{hb, sumsq + 4 * T};
        pg8::gemm_phase(lds, g, S, E);
    }
#if (REP_MASK >> 15) & 1
    grid.sync();
    if (IN(PH_G8)) {
        pg8::Gemm g{(const bf16_t*)(ws + WS_ACT1), (const bf16_t*)(ws + WS_WT8), T, DM, FF}; pg8::StaticOrder S; S.init(T, DM, G, (int)blockIdx.x);
        EpiResid E{hb, sumsq + 4 * T};
        pg8::gemm_phase(lds, g, S, E);
    }
#endif
    SEAM(PH_G8);
#ifdef EXTRA_SYNCS
    for (int q_ = 0; q_ < EXTRA_SYNCS; ++q_) grid.sync();
#endif
    if (IN(PH_FIN)) {
        const float* fg = p.in[21];
        u32x4 nh[4]; u64 nsq = 0;
        if (gw < T) { const u32x4* hr = (const u32x4*)(hb + (size_t)gw * DM);
#pragma unroll
            for (int j = 0; j < 4; ++j) nh[j] = hr[j * 64 + lane];
            nsq = sumsq[4 * T + gw]; }
        for (int m = gw; m < T; m += ngw) {
            u32x4 ch_[4]; const u64 csq = nsq;
#pragma unroll
            for (int j = 0; j < 4; ++j) ch_[j] = nh[j];
            { const int mn = m + ngw < T ? m + ngw : m; const u32x4* hr = (const u32x4*)(hb + (size_t)mn * DM);
#pragma unroll
              for (int j = 0; j < 4; ++j) nh[j] = hr[j * 64 + lane];
              nsq = sumsq[4 * T + mn]; }
            const float rs = ss_rstd(&csq, 0);
            f32x4* orow = (f32x4*)(out + (size_t)m * DM);
#pragma unroll
            for (int j = 0; j < 4; ++j) { float v[8]; unpack8(ch_[j], v);
                const f32x4 g0 = *((const f32x4*)fg + 2 * (j * 64 + lane)), g1 = *((const f32x4*)fg + 2 * (j * 64 + lane) + 1);
                orow[2 * (j * 64 + lane)] = (f32x4){v[0] * rs * g0[0], v[1] * rs * g0[1], v[2] * rs * g0[2], v[3] * rs * g0[3]};
                orow[2 * (j * 64 + lane) + 1] = (f32x4){v[4] * rs * g1[0], v[5] * rs * g1[1], v[6] * rs * g1[2], v[7] * rs * g1[3]}; }
        }
    }
#undef IN
#undef SEAM
}

#ifndef MK_PER_PHASE
#define MK_PER_PHASE 0
#endif
extern "C" void kernel_launch(void* const* d_in, const int* in_sizes, int n_in, void* d_out, int out_size, void* d_ws, size_t ws_size, hipStream_t stream) {
    static int grid = 0;
    if (grid == 0) {
        if (n_in != 22 || out_size != T * DM || ws_size < WS_END) { fprintf(stderr, "kernel_launch: unexpected shapes (n_in %d out %d ws %zu)\n", n_in, out_size, ws_size); grid = -1; return; }
        int dev = 0, cus = 0, per_cu = 0;
        (void)hipGetDevice(&dev); (void)hipDeviceGetAttribute(&cus, hipDeviceAttributeMultiprocessorCount, dev);
        if (hipFuncSetAttribute((const void*)mega, hipFuncAttributeMaxDynamicSharedMemorySize, LDS_BYTES) != hipSuccess) { fprintf(stderr, "kernel_launch: hipFuncSetAttribute failed\n"); grid = -1; return; }
        if (hipOccupancyMaxActiveBlocksPerMultiprocessor(&per_cu, (const void*)mega, 512, LDS_BYTES) != hipSuccess || per_cu < 1) { fprintf(stderr, "kernel_launch: occupancy query gave %d\n", per_cu); per_cu = 1; }
        (void)hipGetLastError();
        grid = cus * 1;
        if (grid <= 0) grid = 256;
    }
    if (grid < 0) return;
    Params p{};
    for (int i = 0; i < 22; ++i) p.in[i] = (const float*)d_in[i];
    p.out = (float*)d_out; p.ws = (unsigned char*)d_ws;
#if MK_PER_PHASE
    for (int ph = 0; ph < PH_N; ++ph) { p.ph_lo = ph; p.ph_hi = ph + 1; hipLaunchKernelGGL(mega, dim3(grid), dim3(512), LDS_BYTES, stream, p); }
#else
    p.ph_lo = 0; p.ph_hi = PH_N;
    void* args[] = {&p};
    hipError_t e = hipLaunchCooperativeKernel((const void*)mega, dim3(grid), dim3(512), args, LDS_BYTES, stream);
    if (e != hipSuccess) fprintf(stderr, "kernel_launch: cooperative launch failed: %s (grid %d)\n", hipGetErrorString(e), grid);
#endif
}
```
